# Optimizing an MI355X kernel written in HIP

```python
import math
import jax, jax.numpy as jnp
from jax import lax
import numpy as np

D_MODEL = 1024
BATCH = 8
SEQ = 4096
DEPTH = 4

GRID_W = 64
CTX_LEN = 256
HEAD_DIM = 64
A_HEADS = 4
A_VDIM = 2 * HEAD_DIM
A_WIDTH = A_HEADS * A_VDIM
B_HEADS = 8
B_KV_HEADS = 2
B_REP = B_HEADS // B_KV_HEADS
B_WIDTH = B_HEADS * HEAD_DIM
A_Q_COLS = A_HEADS * 2 * HEAD_DIM
A_K_COLS = A_HEADS * 2 * HEAD_DIM
A_V_COLS = A_WIDTH
B_Q_COLS = B_HEADS * HEAD_DIM
B_K_COLS = B_KV_HEADS * HEAD_DIM
B_V_COLS = B_KV_HEADS * HEAD_DIM
IN_COLS = A_Q_COLS + A_K_COLS + A_V_COLS + B_Q_COLS + B_K_COLS + B_V_COLS
IN_SPLITS = (A_Q_COLS,
             A_Q_COLS + A_K_COLS,
             A_Q_COLS + A_K_COLS + A_V_COLS,
             A_Q_COLS + A_K_COLS + A_V_COLS + B_Q_COLS,
             A_Q_COLS + A_K_COLS + A_V_COLS + B_Q_COLS + B_K_COLS)
MIX_WIDTH = A_WIDTH + B_WIDTH
CONV_WIDTH = 3
MLP_HIDDEN = 4 * D_MODEL
ROPE_THETA = 10000.0
ROPE_FREQS = HEAD_DIM // 4
Q_BLOCK = 128
N_EVEN = (DEPTH + 1) // 2
N_ODD = DEPTH // 2
N_MOD = 6
DEEPNORM_ALPHA = (2 * DEPTH) ** 0.25
DEEPNORM_BETA = (8 * DEPTH) ** -0.25
EPS = 1e-6

kernel_name = "hybrid_diffattn_gqa_shortconv_dit_trunk"


def layer_norm(x, g, b):
    xf = x.astype(jnp.float32)
    mu = jnp.mean(xf, axis=-1, keepdims=True)
    var = jnp.mean(jnp.square(xf - mu), axis=-1, keepdims=True)
    return ((xf - mu) * lax.rsqrt(var + EPS) * g + b).astype(x.dtype)


def rms_norm(x, g):
    xf = x.astype(jnp.float32)
    return (xf * lax.rsqrt(jnp.mean(xf * xf, axis=-1, keepdims=True) + EPS) * g).astype(x.dtype)


def modulate(h, shift, scale):
    return h * (1.0 + scale) + shift


def rope_tables(n_tokens):
    rows = n_tokens // GRID_W
    row = jnp.broadcast_to(jnp.arange(rows)[:, None], (rows, GRID_W)).reshape(-1).astype(jnp.float32)
    col = jnp.broadcast_to(jnp.arange(GRID_W)[None, :], (rows, GRID_W)).reshape(-1).astype(jnp.float32)
    inv_freq = ROPE_THETA ** (-jnp.arange(ROPE_FREQS, dtype=jnp.float32) / ROPE_FREQS)
    ang = jnp.stack([row, col], axis=-1)[:, :, None] * inv_freq
    return jnp.cos(ang), jnp.sin(ang)


def apply_rope_2d(x, cos, sin):
    shp = x.shape
    xs = x.astype(jnp.float32).reshape(*shp[:-1], 2, 2, ROPE_FREQS)
    x1, x2 = xs[..., 0, :], xs[..., 1, :]
    n_head_axes = x.ndim - 3
    c = cos.reshape(cos.shape[0], *([1] * n_head_axes), 2, ROPE_FREQS)
    s = sin.reshape(sin.shape[0], *([1] * n_head_axes), 2, ROPE_FREQS)
    o1 = x1 * c - x2 * s
    o2 = x2 * c + x1 * s
    return jnp.stack([o1, o2], axis=-2).reshape(shp).astype(x.dtype)


def diff_attention(q, k, v, lam, lam_init, subln_g):
    s = jnp.einsum('bqhid,bkhid->bhiqk', q, k) * (HEAD_DIM ** -0.5)
    p = jax.nn.softmax(s.astype(jnp.float32), axis=-1)
    attn = (p[:, :, 0] - lam * p[:, :, 1]).astype(v.dtype)
    o = jnp.einsum('bhqk,bkhe->bqhe', attn, v)
    o = rms_norm(o, subln_g) * (1.0 - lam_init)
    return o.reshape(o.shape[0], o.shape[1], A_WIDTH)


def gqa_attention(q, k, v):
    bsz, nq = q.shape[0], q.shape[1]
    q = q.reshape(bsz, nq, B_KV_HEADS, B_REP, HEAD_DIM)
    s = jnp.einsum('bqgrd,bkgd->bgrqk', q, k) * (HEAD_DIM ** -0.5)
    p = jax.nn.softmax(s.astype(jnp.float32), axis=-1).astype(v.dtype)
    o = jnp.einsum('bgrqk,bkgd->bqgrd', p, v)
    return o.reshape(bsz, nq, B_WIDTH)


def even_mixer(h_lat, h_ctx, w_in, w_out, lam_vecs, subln_g, qn_g, kn_g, lam_init, cos, sin, ctx_out):
    bsz, n_lat = h_lat.shape[0], h_lat.shape[1]

    def project(h, use_rope):
        n = h.shape[1]
        z = h @ w_in
        aq, ak, av, bq, bk, bv = jnp.split(z, IN_SPLITS, axis=-1)
        aq = aq.reshape(bsz, n, A_HEADS, 2, HEAD_DIM)
        ak = ak.reshape(bsz, n, A_HEADS, 2, HEAD_DIM)
        av = av.reshape(bsz, n, A_HEADS, A_VDIM)
        bq = rms_norm(bq.reshape(bsz, n, B_HEADS, HEAD_DIM), qn_g)
        bk = rms_norm(bk.reshape(bsz, n, B_KV_HEADS, HEAD_DIM), kn_g)
        bv = bv.reshape(bsz, n, B_KV_HEADS, HEAD_DIM)
        if use_rope:
            aq = apply_rope_2d(aq, cos, sin)
            ak = apply_rope_2d(ak, cos, sin)
            bq = apply_rope_2d(bq, cos, sin)
            bk = apply_rope_2d(bk, cos, sin)
        return aq, ak, av, bq, bk, bv

    lv = lam_vecs.astype(jnp.float32)
    lam = jnp.exp(jnp.sum(lv[0] * lv[1])) - jnp.exp(jnp.sum(lv[2] * lv[3])) + lam_init

    caq, cak, cav, cbq, cbk, cbv = project(h_ctx, False)
    laq, lak, lav, lbq, lbk, lbv = project(h_lat, True)
    ak_all = jnp.concatenate([cak, lak], axis=1)
    av_all = jnp.concatenate([cav, lav], axis=1)
    bk_all = jnp.concatenate([cbk, lbk], axis=1)
    bv_all = jnp.concatenate([cbv, lbv], axis=1)

    nb = n_lat // Q_BLOCK

    def to_blocks(t):
        return jnp.moveaxis(t.reshape(bsz, nb, Q_BLOCK, *t.shape[2:]), 1, 0)

    def block(qs):
        qa, qb = qs
        return jnp.concatenate([diff_attention(qa, ak_all, av_all, lam, lam_init, subln_g),
                                gqa_attention(qb, bk_all, bv_all)], axis=-1)

    o = lax.map(block, (to_blocks(laq), to_blocks(lbq)))
    o = jnp.moveaxis(o, 0, 1).reshape(bsz, n_lat, MIX_WIDTH)
    y_lat = o @ w_out
    y_ctx = None
    if ctx_out:
        oc = jnp.concatenate([diff_attention(caq, cak, cav, lam, lam_init, subln_g),
                              gqa_attention(cbq, cbk, cbv)], axis=-1)
        y_ctx = oc @ w_out
    return y_lat, y_ctx


def conv_mixer(h, w_in, conv_w, conv_b, w_out):
    n = h.shape[1]
    z = h @ w_in
    gate_b, gate_c, xv = jnp.split(z, 3, axis=-1)
    u = gate_c * xv
    up = jnp.pad(u, ((0, 0), (1, 1), (0, 0)))
    y = up[:, :n] * conv_w[0] + up[:, 1:n + 1] * conv_w[1] + up[:, 2:n + 2] * conv_w[2] + conv_b
    return (gate_b * y) @ w_out


def sq_relu_mlp(h, w1, w2):
    return jnp.square(jax.nn.relu(h @ w1)) @ w2


def setup_inputs(seed: int = 0) -> dict:
    key = jax.random.key(seed)
    ks = jax.random.split(key, 20)
    f32 = jnp.float32
    nrm = lambda k, shp: jax.random.normal(k, shp, f32)
    d = D_MODEL
    return {
        "x": nrm(ks[0], (BATCH, SEQ, d)),
        "c": nrm(ks[1], (BATCH, d)),
        "ctx": nrm(ks[2], (BATCH, CTX_LEN, d)),
        "c_ctx": nrm(ks[3], (d,)),
        "ada_w": nrm(ks[4], (DEPTH, d, N_MOD * d)) * (0.5 * d ** -0.5),
        "ada_b": nrm(ks[5], (DEPTH, N_MOD * d)) * 0.02,
        "attn_w_in": nrm(ks[6], (N_EVEN, d, IN_COLS)) * d ** -0.5,
        "attn_w_out": nrm(ks[7], (N_EVEN, MIX_WIDTH, d)) * (MIX_WIDTH ** -0.5 * DEEPNORM_BETA),
        "diff_lambda": nrm(ks[8], (N_EVEN, 4, HEAD_DIM)) * 0.1,
        "diff_subln_g": 1.0 + 0.02 * nrm(ks[9], (N_EVEN, A_VDIM)),
        "q_norm_g": 1.0 + 0.02 * nrm(ks[10], (N_EVEN, HEAD_DIM)),
        "k_norm_g": 1.0 + 0.02 * nrm(ks[11], (N_EVEN, HEAD_DIM)),
        "conv_w_in": nrm(ks[12], (N_ODD, d, 3 * d)) * d ** -0.5,
        "conv_w": nrm(ks[13], (N_ODD, CONV_WIDTH, d)) * CONV_WIDTH ** -0.5,
        "conv_b": nrm(ks[14], (N_ODD, d)) * 0.02,
        "conv_w_out": nrm(ks[15], (N_ODD, d, d)) * (d ** -0.5 * DEEPNORM_BETA),
        "mlp_w1": nrm(ks[16], (DEPTH, d, MLP_HIDDEN)) * d ** -0.5,
        "mlp_w2": nrm(ks[17], (DEPTH, MLP_HIDDEN, d)) * (MLP_HIDDEN ** -0.5 * DEEPNORM_BETA),
        "ln_g": 1.0 + 0.02 * nrm(ks[18], (DEPTH, 2, d)),
        "ln_b": 0.02 * nrm(ks[19], (DEPTH, 2, d)),
    }


def reference(x, c, ctx, c_ctx, ada_w, ada_b, attn_w_in, attn_w_out, diff_lambda, diff_subln_g,
              q_norm_g, k_norm_g, conv_w_in, conv_w, conv_b, conv_w_out, mlp_w1, mlp_w2, ln_g, ln_b):
    n_lat = x.shape[1]
    cos, sin = rope_tables(n_lat)
    c_act = jax.nn.silu(c)
    cc_act = jax.nn.silu(c_ctx)
    x_ctx = ctx
    for l in range(DEPTH):
        even = (l % 2 == 0)
        ctx_out = any(j % 2 == 0 for j in range(l + 1, DEPTH))
        need_ctx = even or ctx_out
        mod = (c_act @ ada_w[l] + ada_b[l])[:, None, :]
        sh1, sc1, g1, sh2, sc2, g2 = jnp.split(mod, N_MOD, axis=-1)
        h = modulate(x, sh1, sc1)
        if need_ctx:
            mod_c = cc_act @ ada_w[l] + ada_b[l]
            csh1, csc1, cg1, csh2, csc2, cg2 = jnp.split(mod_c, N_MOD, axis=-1)
            hc = modulate(x_ctx, csh1, csc1)
        if even:
            e = l // 2
            lam_init = 0.8 - 0.6 * math.exp(-0.3 * l)
            y, yc = even_mixer(h, hc, attn_w_in[e], attn_w_out[e], diff_lambda[e], diff_subln_g[e],
                               q_norm_g[e], k_norm_g[e], lam_init, cos, sin, ctx_out)
        else:
            o = l // 2
            y = conv_mixer(h, conv_w_in[o], conv_w[o], conv_b[o], conv_w_out[o])
            yc = conv_mixer(hc, conv_w_in[o], conv_w[o], conv_b[o], conv_w_out[o]) if ctx_out else None
        x = layer_norm(DEEPNORM_ALPHA * x + g1 * y, ln_g[l, 0], ln_b[l, 0])
        h = modulate(x, sh2, sc2)
        x = layer_norm(DEEPNORM_ALPHA * x + g2 * sq_relu_mlp(h, mlp_w1[l], mlp_w2[l]), ln_g[l, 1], ln_b[l, 1])
        if ctx_out:
            x_ctx = layer_norm(DEEPNORM_ALPHA * x_ctx + cg1 * yc, ln_g[l, 0], ln_b[l, 0])
            hc = modulate(x_ctx, csh2, csc2)
            x_ctx = layer_norm(DEEPNORM_ALPHA * x_ctx + cg2 * sq_relu_mlp(hc, mlp_w1[l], mlp_w2[l]),
                               ln_g[l, 1], ln_b[l, 1])
    return x
```

```cpp
#include <hip/hip_runtime.h>
#include <hip/hip_cooperative_groups.h>
#include <hip/hip_bf16.h>
#include <cstdio>
#include <cstdint>
#include <cmath>
namespace cg = cooperative_groups;
__device__ const float ROPE_COS[1024]={
1.00000000e+00f,1.00000000e+00f,1.00000000e+00f,1.00000000e+00f,1.00000000e+00f,1.00000000e+00f,1.00000000e+00f,1.00000000e+00f,1.00000000e+00f,1.00000000e+00f,1.00000000e+00f,1.00000000e+00f,1.00000000e+00f,1.00000000e+00f,1.00000000e+00f,1.00000000e+00f,
5.40302277e-01f,8.46009135e-01f,9.50415254e-01f,9.84230220e-01f,9.95004177e-01f,9.98419285e-01f,9.99500036e-01f,9.99841869e-01f,9.99949992e-01f,9.99984205e-01f,9.99994993e-01f,9.99998391e-01f,9.99999523e-01f,9.99999821e-01f,9.99999940e-01f,1.00000000e+00f,
-4.16146845e-01f,4.31462824e-01f,8.06578398e-01f,9.37418282e-01f,9.80066597e-01f,9.93682086e-01f,9.98000681e-01f,9.99367595e-01f,9.99800026e-01f,9.99936759e-01f,9.99979973e-01f,9.99993682e-01f,9.99997973e-01f,9.99999344e-01f,9.99999821e-01f,9.99999940e-01f,
-9.89992499e-01f,-1.15966164e-01f,5.82753658e-01f,8.61040652e-01f,9.55336511e-01f,9.85803485e-01f,9.95503366e-01f,9.98577297e-01f,9.99550045e-01f,9.99857724e-01f,9.99954998e-01f,9.99985754e-01f,9.99995530e-01f,9.99998569e-01f,9.99999523e-01f,9.99999881e-01f,
-6.53643608e-01f,-6.27679706e-01f,3.01137477e-01f,7.57506192e-01f,9.21060979e-01f,9.74808276e-01f,9.92010653e-01f,9.97471273e-01f,9.99200106e-01f,9.99747038e-01f,9.99920011e-01f,9.99974728e-01f,9.99992013e-01f,9.99997497e-01f,9.99999225e-01f,9.99999762e-01f,
2.83662200e-01f,-9.46079254e-01f,-1.03423381e-02f,6.30080283e-01f,8.77582550e-01f,9.60731268e-01f,9.87526000e-01f,9.96049762e-01f,9.98750269e-01f,9.99604762e-01f,9.99875009e-01f,9.99960482e-01f,9.99987483e-01f,9.99996066e-01f,9.99998748e-01f,9.99999583e-01f,
9.60170269e-01f,-9.73103702e-01f,-3.20796400e-01f,4.82782036e-01f,8.25335622e-01f,9.43616986e-01f,9.82053936e-01f,9.94313300e-01f,9.98200536e-01f,9.99430835e-01f,9.99819994e-01f,9.99943078e-01f,9.99981999e-01f,9.99994338e-01f,9.99998212e-01f,9.99999404e-01f,
7.53902256e-01f,-7.00429797e-01f,-5.99437475e-01f,3.20257008e-01f,7.64842212e-01f,9.23519433e-01f,9.75599885e-01f,9.92262423e-01f,9.97551024e-01f,9.99225318e-01f,9.99755025e-01f,9.99922514e-01f,9.99975502e-01f,9.99992251e-01f,9.99997556e-01f,9.99999225e-01f,
-1.45500034e-01f,-2.12036446e-01f,-8.18632424e-01f,1.47631213e-01f,6.96706712e-01f,9.00502324e-01f,9.68170285e-01f,9.89897788e-01f,9.96801734e-01f,9.98988271e-01f,9.99680042e-01f,9.99898791e-01f,9.99967992e-01f,9.99989867e-01f,9.99996781e-01f,9.99998987e-01f,
-9.11130250e-01f,3.41660261e-01f,-9.56644177e-01f,-2.96507962e-02f,6.21609926e-01f,8.74638259e-01f,9.59772646e-01f,9.87220109e-01f,9.95952725e-01f,9.98719573e-01f,9.99595046e-01f,9.99871910e-01f,9.99959528e-01f,9.99987185e-01f,9.99995947e-01f,9.99998748e-01f,
-8.39071512e-01f,7.90131867e-01f,-9.99786079e-01f,-2.05997631e-01f,5.40302277e-01f,8.46009135e-01f,9.50415313e-01f,9.84230220e-01f,9.95004177e-01f,9.98419285e-01f,9.99500036e-01f,9.99841869e-01f,9.99949992e-01f,9.99984205e-01f,9.99994993e-01f,9.99998391e-01f,
4.42569796e-03f,9.95257378e-01f,-9.43779767e-01f,-3.75847399e-01f,4.53596085e-01f,8.14705312e-01f,9.40107584e-01f,9.80929136e-01f,9.93956089e-01f,9.98087406e-01f,9.99395072e-01f,9.99808669e-01f,9.99939501e-01f,9.99980867e-01f,9.99993920e-01f,9.99998093e-01f,
8.43853951e-01f,8.93861592e-01f,-7.94179380e-01f,-5.33843040e-01f,3.62357706e-01f,7.80825913e-01f,9.28859890e-01f,9.77317870e-01f,9.92808640e-01f,9.97723997e-01f,9.99280095e-01f,9.99772310e-01f,9.99927998e-01f,9.99977231e-01f,9.99992788e-01f,9.99997735e-01f,
9.07446802e-01f,5.17172873e-01f,-5.65820515e-01f,-6.75001681e-01f,2.67498761e-01f,7.44477987e-01f,9.16683376e-01f,9.73397553e-01f,9.91561890e-01f,9.97329056e-01f,9.99155104e-01f,9.99732792e-01f,9.99915481e-01f,9.99973297e-01f,9.99991536e-01f,9.99997318e-01f,
1.36737213e-01f,-1.87961515e-02f,-2.81349480e-01f,-7.94870913e-01f,1.69967160e-01f,7.05776393e-01f,9.03590262e-01f,9.69169438e-01f,9.90216017e-01f,9.96902585e-01f,9.99020159e-01f,9.99690115e-01f,9.99902010e-01f,9.99969006e-01f,9.99990225e-01f,9.99996901e-01f,
-7.59687901e-01f,-5.48975468e-01f,3.10223512e-02f,-8.89670432e-01f,7.07371980e-02f,6.64843500e-01f,8.89593601e-01f,9.64634836e-01f,9.88771081e-01f,9.96444523e-01f,9.98875201e-01f,9.99644279e-01f,9.99887526e-01f,9.99964416e-01f,9.99988735e-01f,9.99996424e-01f,
-9.57659483e-01f,-9.10081089e-01f,3.40318173e-01f,-9.56410050e-01f,-2.91995462e-02f,6.21808827e-01f,8.74707460e-01f,9.59795177e-01f,9.87227261e-01f,9.95954990e-01f,9.98720288e-01f,9.99595284e-01f,9.99872029e-01f,9.99959528e-01f,9.99987185e-01f,9.99995947e-01f,
-2.75163352e-01f,-9.90897954e-01f,6.15864813e-01f,-9.92985010e-01f,-1.28844544e-01f,5.76808274e-01f,8.58946681e-01f,9.54652011e-01f,9.85584795e-01f,9.95433986e-01f,9.98555362e-01f,9.99543071e-01f,9.99855518e-01f,9.99954283e-01f,9.99985576e-01f,9.99995410e-01f,
6.60316706e-01f,-7.66536534e-01f,8.30336154e-01f,-9.98241663e-01f,-2.27202162e-01f,5.29984176e-01f,8.42327058e-01f,9.49207008e-01f,9.83843684e-01f,9.94881511e-01f,9.98380423e-01f,9.99487758e-01f,9.99837995e-01f,9.99948800e-01f,9.99983788e-01f,9.99994874e-01f,
9.88704622e-01f,-3.06095392e-01f,9.62463796e-01f,-9.72014248e-01f,-3.23289543e-01f,4.81484592e-01f,8.24865162e-01f,9.43461835e-01f,9.82004225e-01f,9.94297504e-01f,9.98195529e-01f,9.99429286e-01f,9.99819517e-01f,9.99942899e-01f,9.99981940e-01f,9.99994278e-01f,
4.08082068e-01f,2.48616725e-01f,9.99144375e-01f,-9.15129960e-01f,-4.16146845e-01f,4.31462824e-01f,8.06578457e-01f,9.37418282e-01f,9.80066597e-01f,9.93682086e-01f,9.98000681e-01f,9.99367595e-01f,9.99800026e-01f,9.99936759e-01f,9.99979973e-01f,9.99993682e-01f,
-5.47729254e-01f,7.26760268e-01f,9.36740458e-01f,-8.29382956e-01f,-5.04846215e-01f,3.80077004e-01f,7.87485182e-01f,9.31078374e-01f,9.78030920e-01f,9.93035257e-01f,9.97795820e-01f,9.99302804e-01f,9.99779522e-01f,9.99930263e-01f,9.99977946e-01f,9.99993026e-01f,
-9.99960840e-01f,9.81074572e-01f,7.81440377e-01f,-7.17477441e-01f,-5.88501155e-01f,3.27489585e-01f,7.67604589e-01f,9.24443960e-01f,9.75897431e-01f,9.92357016e-01f,9.97581005e-01f,9.99234855e-01f,9.99758005e-01f,9.99923468e-01f,9.99975801e-01f,9.99992371e-01f,
-5.32833040e-01f,9.33235765e-01f,5.48645258e-01f,-5.82943261e-01f,-6.66275978e-01f,2.73866832e-01f,7.46956408e-01f,9.17517304e-01f,9.73666370e-01f,9.91647422e-01f,9.97356176e-01f,9.99163687e-01f,9.99735534e-01f,9.99916375e-01f,9.99973536e-01f,9.99991655e-01f,
4.24179018e-01f,5.97977161e-01f,2.61441678e-01f,-4.30023283e-01f,-7.37393796e-01f,2.19378278e-01f,7.25561321e-01f,9.10300434e-01f,9.71337974e-01f,9.90906477e-01f,9.97121394e-01f,9.99089420e-01f,9.99711990e-01f,9.99908924e-01f,9.99971211e-01f,9.99990880e-01f,
9.91202831e-01f,7.85522610e-02f,-5.16893305e-02f,-2.63540596e-01f,-8.01143587e-01f,1.64196163e-01f,7.03440726e-01f,9.02795732e-01f,9.68912423e-01f,9.90134120e-01f,9.96876657e-01f,9.99011934e-01f,9.99687493e-01f,9.99901175e-01f,9.99968767e-01f,9.99990106e-01f,
6.46919310e-01f,-4.65064496e-01f,-3.59694332e-01f,-8.87455046e-02f,-8.56888831e-01f,1.08494945e-01f,6.80616796e-01f,8.95005584e-01f,9.66389954e-01f,9.89330530e-01f,9.96621907e-01f,9.98931348e-01f,9.99662042e-01f,9.99893129e-01f,9.99966204e-01f,9.99989331e-01f,
-2.92138815e-01f,-8.65450621e-01f,-6.32028639e-01f,8.88481140e-02f,-9.04072165e-01f,5.24506159e-02f,6.57112300e-01f,8.86932373e-01f,9.63770926e-01f,9.88495648e-01f,9.96357203e-01f,9.98847544e-01f,9.99635518e-01f,9.99884725e-01f,9.99963522e-01f,9.99988496e-01f,
-9.62605894e-01f,-9.99293387e-01f,-8.41684937e-01f,2.63639510e-01f,-9.42222297e-01f,-3.75941908e-03f,6.32950664e-01f,8.78578722e-01f,9.61055458e-01f,9.87629473e-01f,9.96082544e-01f,9.98760641e-01f,9.99608040e-01f,9.99876022e-01f,9.99960780e-01f,9.99987602e-01f,
-7.48057544e-01f,-8.25371623e-01f,-9.67871487e-01f,4.30115849e-01f,-9.70958173e-01f,-5.99575676e-02f,6.08156204e-01f,8.69947195e-01f,9.58243906e-01f,9.86732066e-01f,9.95797932e-01f,9.98670578e-01f,9.99579549e-01f,9.99867022e-01f,9.99957979e-01f,9.99986708e-01f,
1.54251456e-01f,-3.97251874e-01f,-9.98075247e-01f,5.83026946e-01f,-9.89992499e-01f,-1.15966164e-01f,5.82753658e-01f,8.61040652e-01f,9.55336511e-01f,9.85803485e-01f,9.95503366e-01f,9.98577297e-01f,9.99550045e-01f,9.99857724e-01f,9.99954998e-01f,9.99985754e-01f,
9.14742351e-01f,1.53215483e-01f,-9.29300308e-01f,7.17549205e-01f,-9.99135137e-01f,-1.71608135e-01f,5.56768358e-01f,8.51861775e-01f,9.52333570e-01f,9.84843671e-01f,9.95198846e-01f,9.98480916e-01f,9.99519527e-01f,9.99848068e-01f,9.99951959e-01f,9.99984801e-01f,
8.34223390e-01f,6.56495154e-01f,-7.68367112e-01f,8.29440355e-01f,-9.98294771e-01f,-2.26707578e-01f,5.30226350e-01f,8.42413545e-01f,9.49235439e-01f,9.83852804e-01f,9.94884372e-01f,9.98381376e-01f,9.99488056e-01f,9.99838114e-01f,9.99948800e-01f,9.99983788e-01f,
-1.32767474e-02f,9.57586050e-01f,-5.31235278e-01f,9.15171385e-01f,-9.87479806e-01f,-2.81090319e-01f,5.03154159e-01f,8.32698941e-01f,9.46042359e-01f,9.82830763e-01f,9.94559944e-01f,9.98278618e-01f,9.99455571e-01f,9.99827802e-01f,9.99945521e-01f,9.99982774e-01f,
-8.48570287e-01f,9.63757515e-01f,-2.41421118e-01f,9.72038329e-01f,-9.66798186e-01f,-3.34584385e-01f,4.75578904e-01f,8.22721004e-01f,9.42754686e-01f,9.81777668e-01f,9.94225562e-01f,9.98172760e-01f,9.99422073e-01f,9.99817252e-01f,9.99942183e-01f,9.99981701e-01f,
-9.03692186e-01f,6.73110247e-01f,7.23346695e-02f,9.98247743e-01f,-9.36456680e-01f,-3.87020677e-01f,4.47528064e-01f,8.12482953e-01f,9.39372718e-01f,9.80693519e-01f,9.93881226e-01f,9.98063743e-01f,9.99387562e-01f,9.99806345e-01f,9.99938726e-01f,9.99980628e-01f,
-1.27963692e-01f,1.75156534e-01f,3.78916174e-01f,9.92972851e-01f,-8.96758378e-01f,-4.38233554e-01f,4.19029742e-01f,8.01987886e-01f,9.35896814e-01f,9.79578316e-01f,9.93526995e-01f,9.97951567e-01f,9.99352098e-01f,9.99795079e-01f,9.99935210e-01f,9.99979496e-01f,
7.65414059e-01f,-3.76742303e-01f,6.47921681e-01f,9.56380010e-01f,-8.48100007e-01f,-4.88060862e-01f,3.90112430e-01f,7.91239262e-01f,9.32327330e-01f,9.78432178e-01f,9.93162811e-01f,9.97836173e-01f,9.99315560e-01f,9.99783576e-01f,9.99931574e-01f,9.99978364e-01f,
9.55073655e-01f,-8.12611222e-01f,8.52673113e-01f,8.89623463e-01f,-7.90967762e-01f,-5.36345184e-01f,3.60805035e-01f,7.80240417e-01f,9.28664625e-01f,9.77255106e-01f,9.92788672e-01f,9.97717679e-01f,9.99278069e-01f,9.99771714e-01f,9.99927819e-01f,9.99977171e-01f,
2.66642928e-01f,-9.98210371e-01f,9.72865343e-01f,7.94808388e-01f,-7.25932240e-01f,-5.82933903e-01f,3.31136853e-01f,7.68994927e-01f,9.24909055e-01f,9.76047099e-01f,9.92404640e-01f,9.97596025e-01f,9.99239624e-01f,9.99759495e-01f,9.99923944e-01f,9.99975979e-01f,
-6.66938066e-01f,-8.76379430e-01f,9.96578991e-01f,6.74925625e-01f,-6.53643608e-01f,-6.27679706e-01f,3.01137596e-01f,7.57506192e-01f,9.21060979e-01f,9.74808276e-01f,9.92010653e-01f,9.97471273e-01f,9.99200106e-01f,9.99747038e-01f,9.99920011e-01f,9.99974728e-01f,
-9.87339258e-01f,-4.84639406e-01f,9.21462357e-01f,5.33756077e-01f,-5.74824035e-01f,-6.70441091e-01f,2.70837069e-01f,7.45777905e-01f,9.17120814e-01f,9.73538578e-01f,9.91606772e-01f,9.97343302e-01f,9.99159634e-01f,9.99734223e-01f,9.99915957e-01f,9.99973416e-01f,
-3.99985313e-01f,5.63609414e-02f,7.54965365e-01f,3.75752151e-01f,-4.90260571e-01f,-7.11082935e-01f,2.40265876e-01f,7.33813822e-01f,9.13088918e-01f,9.72238123e-01f,9.91192937e-01f,9.97212172e-01f,9.99118149e-01f,9.99721110e-01f,9.99911785e-01f,9.99972105e-01f,
5.55113316e-01f,5.80003142e-01f,5.13598442e-01f,2.05897167e-01f,-4.00799006e-01f,-7.49476731e-01f,2.09454417e-01f,7.21617639e-01f,9.08965766e-01f,9.70906913e-01f,9.90769207e-01f,9.97077882e-01f,9.99075651e-01f,9.99707639e-01f,9.99907553e-01f,9.99970794e-01f,
9.99843299e-01f,9.25014675e-01f,2.21298173e-01f,2.95478199e-02f,-3.07332784e-01f,-7.85501122e-01f,1.78433523e-01f,7.09193349e-01f,9.04751658e-01f,9.69545007e-01f,9.90335584e-01f,9.96940494e-01f,9.99032140e-01f,9.99693930e-01f,9.99903202e-01f,9.99969363e-01f,
5.25321960e-01f,9.85138178e-01f,-9.29481089e-02f,-1.47732988e-01f,-2.10795805e-01f,-8.19042206e-01f,1.47234216e-01f,6.96544766e-01f,9.00447130e-01f,9.68152404e-01f,9.89892066e-01f,9.96799886e-01f,9.98987675e-01f,9.99679863e-01f,9.99898732e-01f,9.99967992e-01f,
-4.32177931e-01f,7.41858006e-01f,-3.97976756e-01f,-3.20354372e-01f,-1.12152621e-01f,-8.49993885e-01f,1.15887694e-01f,6.83675885e-01f,8.96052480e-01f,9.66729224e-01f,9.89438653e-01f,9.96656179e-01f,9.98942196e-01f,9.99665439e-01f,9.99894202e-01f,9.99966562e-01f,
-9.92335498e-01f,2.70098448e-01f,-6.63538277e-01f,-4.82871950e-01f,-1.23883775e-02f,-8.78258407e-01f,8.44252855e-02f,6.70590878e-01f,8.91568303e-01f,9.65275466e-01f,9.88975346e-01f,9.96509314e-01f,9.98895705e-01f,9.99650776e-01f,9.99889553e-01f,9.99965072e-01f,
-6.40144348e-01f,-2.84846604e-01f,-8.63296509e-01f,-6.30159974e-01f,8.74991715e-02f,-9.03746367e-01f,5.28784581e-02f,6.57293737e-01f,8.86994898e-01f,9.63791192e-01f,9.88502085e-01f,9.96359289e-01f,9.98848200e-01f,9.99635756e-01f,9.99884784e-01f,9.99963582e-01f,
3.00592542e-01f,-7.52063990e-01f,-9.77442741e-01f,-7.57573068e-01f,1.86512470e-01f,-9.26377118e-01f,2.12787576e-02f,6.43788815e-01f,8.82332861e-01f,9.62276459e-01f,9.88018990e-01f,9.96206105e-01f,9.98799741e-01f,9.99620378e-01f,9.99879956e-01f,9.99962032e-01f,
9.64965999e-01f,-9.87659097e-01f,-9.94656444e-01f,-8.61092687e-01f,2.83662200e-01f,-9.46079254e-01f,-1.03422189e-02f,6.30080283e-01f,8.77582550e-01f,9.60731268e-01f,9.87526000e-01f,9.96049762e-01f,9.98750269e-01f,9.99604762e-01f,9.99875009e-01f,9.99960482e-01f,
7.42154181e-01f,-9.19073522e-01f,-9.13230121e-01f,-9.37454224e-01f,3.77977669e-01f,-9.62790370e-01f,-4.19528559e-02f,6.16172493e-01f,8.72744501e-01f,9.59155679e-01f,9.87023175e-01f,9.95890260e-01f,9.98699784e-01f,9.99588788e-01f,9.99869943e-01f,9.99958873e-01f,
-1.62990779e-01f,-5.67430019e-01f,-7.41239965e-01f,-9.84248459e-01f,4.68516916e-01f,-9.76457715e-01f,-7.35215396e-02f,6.02069914e-01f,8.67819190e-01f,9.57549810e-01f,9.86510456e-01f,9.95727658e-01f,9.98648286e-01f,9.99572515e-01f,9.99864817e-01f,9.99957263e-01f,
-9.18282807e-01f,-4.10281904e-02f,-4.95741814e-01f,-1.00000000e+00f,5.54374516e-01f,-9.87038016e-01f,-1.05016708e-01f,5.87776959e-01f,8.62807095e-01f,9.55913603e-01f,9.85987842e-01f,9.95561838e-01f,9.98595834e-01f,9.99555886e-01f,9.99859571e-01f,9.99955595e-01f,
-8.29309821e-01f,4.98009592e-01f,-2.01079622e-01f,-9.84212041e-01f,6.34692967e-01f,-9.94497895e-01f,-1.36406869e-01f,5.73298037e-01f,8.57708693e-01f,9.54247177e-01f,9.85455394e-01f,9.95392919e-01f,9.98542368e-01f,9.99538958e-01f,9.99854207e-01f,9.99953866e-01f,
2.21267566e-02f,8.83669317e-01f,1.13521777e-01f,-9.37382519e-01f,7.08669782e-01f,-9.98813629e-01f,-1.67660639e-01f,5.58637917e-01f,8.52524519e-01f,9.52550590e-01f,9.84913111e-01f,9.95220840e-01f,9.98487890e-01f,9.99521732e-01f,9.99848783e-01f,9.99952197e-01f,
8.53220105e-01f,9.97174621e-01f,4.16867077e-01f,-8.60988438e-01f,7.75565803e-01f,-9.99971747e-01f,-1.98746875e-01f,5.43801069e-01f,8.47255111e-01f,9.50823903e-01f,9.84360933e-01f,9.95045662e-01f,9.98432398e-01f,9.99504209e-01f,9.99843180e-01f,9.99950409e-01f,
8.99866819e-01f,8.03569078e-01f,6.78870201e-01f,-7.57439196e-01f,8.34712923e-01f,-9.97968495e-01f,-2.29634270e-01f,5.28792322e-01f,8.41901004e-01f,9.49067116e-01f,9.83798921e-01f,9.94867265e-01f,9.98375952e-01f,9.99486327e-01f,9.99837577e-01f,9.99948621e-01f,
1.19180135e-01f,3.62476677e-01f,8.73550534e-01f,-6.30000710e-01f,8.85519624e-01f,-9.92810190e-01f,-2.60292053e-01f,5.13616323e-01f,8.36462677e-01f,9.47280347e-01f,9.83227074e-01f,9.94685769e-01f,9.98318493e-01f,9.99468148e-01f,9.99831796e-01f,9.99946833e-01f,
-7.71080196e-01f,-1.90249100e-01f,9.81602073e-01f,-4.82692331e-01f,9.27478492e-01f,-9.84513164e-01f,-2.90689558e-01f,4.98277903e-01f,8.30940723e-01f,9.45463598e-01f,9.82645452e-01f,9.94501114e-01f,9.98260021e-01f,9.99449670e-01f,9.99825954e-01f,9.99944985e-01f,
-9.52412963e-01f,-6.84381902e-01f,9.92308319e-01f,-3.20159167e-01f,9.60170269e-01f,-9.73103702e-01f,-3.20796400e-01f,4.82782036e-01f,8.25335622e-01f,9.43616986e-01f,9.82053936e-01f,9.94313300e-01f,9.98200536e-01f,9.99430835e-01f,9.99819994e-01f,9.99943078e-01f,
-2.58101642e-01f,-9.67739642e-01f,9.04607594e-01f,-1.47529200e-01f,9.83268440e-01f,-9.58617806e-01f,-3.50582451e-01f,4.67133403e-01f,8.19648027e-01f,9.41740453e-01f,9.81452644e-01f,9.94122326e-01f,9.98140097e-01f,9.99411702e-01f,9.99813974e-01f,9.99941170e-01f,
6.73507154e-01f,-9.53050017e-01f,7.27198064e-01f,2.97537707e-02f,9.96542096e-01f,-9.41101313e-01f,-3.80017966e-01f,4.51337039e-01f,8.13878477e-01f,9.39834237e-01f,9.80841517e-01f,9.93928254e-01f,9.98078644e-01f,9.99392271e-01f,9.99807835e-01f,9.99939203e-01f,
9.85896587e-01f,-6.44837022e-01f,4.77671444e-01f,2.06098333e-01f,9.99858618e-01f,-9.20609534e-01f,-4.09073502e-01f,4.35397953e-01f,8.08027506e-01f,9.37898219e-01f,9.80220556e-01f,9.93731022e-01f,9.98016179e-01f,9.99372482e-01f,9.99801576e-01f,9.99937236e-01f};
__device__ const float ROPE_SIN[1024]={
0.00000000e+00f,0.00000000e+00f,0.00000000e+00f,0.00000000e+00f,0.00000000e+00f,0.00000000e+00f,0.00000000e+00f,0.00000000e+00f,0.00000000e+00f,0.00000000e+00f,0.00000000e+00f,0.00000000e+00f,0.00000000e+00f,0.00000000e+00f,0.00000000e+00f,0.00000000e+00f,
8.41470957e-01f,5.33168435e-01f,3.10983598e-01f,1.76892191e-01f,9.98334214e-02f,5.62044978e-02f,3.16175036e-02f,1.77818574e-02f,9.99983307e-03f,5.62338345e-03f,3.16227227e-03f,1.77827850e-03f,9.99999931e-04f,5.62341243e-04f,3.16227757e-04f,1.77827940e-04f,
9.09297407e-01f,9.02130723e-01f,5.91127098e-01f,3.48205268e-01f,1.98669329e-01f,1.12231314e-01f,6.32033944e-02f,3.55580896e-02f,1.99986659e-02f,1.12465890e-02f,6.32451288e-03f,3.55655141e-03f,1.99999870e-03f,1.12468237e-03f,6.32455456e-04f,3.55655880e-04f,
1.41120002e-01f,9.93253171e-01f,8.12648892e-01f,5.08536100e-01f,2.95520216e-01f,1.67903304e-01f,9.47260857e-02f,5.33230826e-02f,2.99954992e-02f,1.68694388e-02f,9.48669016e-03f,5.33481315e-03f,2.99999560e-03f,1.68702309e-03f,9.48683126e-04f,5.33483806e-04f,
-7.56802499e-01f,7.78471708e-01f,9.53580737e-01f,6.52827978e-01f,3.89418334e-01f,2.23044485e-01f,1.26154065e-01f,7.10712075e-02f,3.99893336e-02f,2.24917568e-02f,1.26487734e-02f,7.11305765e-03f,3.99998948e-03f,2.24936334e-03f,1.26491068e-03f,7.11311703e-04f,
-9.58924294e-01f,3.23935270e-01f,9.99946535e-01f,7.76529968e-01f,4.79425550e-01f,2.77480543e-01f,1.57455876e-01f,8.87968615e-02f,4.99791652e-02f,2.81133614e-02f,1.58107281e-02f,8.89127981e-03f,4.99997940e-03f,2.81170290e-03f,1.58113812e-03f,8.89139599e-04f,
-2.79415488e-01f,-2.30367512e-01f,9.47148204e-01f,8.75740528e-01f,5.64642489e-01f,3.31039310e-01f,1.88600272e-01f,1.06494442e-01f,5.99640049e-02f,3.37340795e-02f,1.89725272e-02f,1.06694745e-02f,5.99996420e-03f,3.37404152e-03f,1.89736532e-03f,1.06696738e-03f,
6.56986594e-01f,-7.13721275e-01f,8.00421596e-01f,9.47330713e-01f,6.44217670e-01f,3.83551568e-01f,2.19556093e-01f,1.24158338e-01f,6.99428469e-02f,3.93537246e-02f,2.21341345e-02f,1.24476347e-02f,6.99994294e-03f,3.93637875e-03f,2.21359241e-03f,1.24479528e-03f,
9.89358246e-01f,-9.77261782e-01f,5.74317753e-01f,9.89042461e-01f,7.17356086e-01f,4.34851229e-01f,2.50292331e-01f,1.41782969e-01f,7.99146891e-02f,4.49721329e-02f,2.52955221e-02f,1.42257558e-02f,7.99991470e-03f,4.49871505e-03f,2.52981926e-03f,1.42262306e-03f,
4.12118495e-01f,-9.39823508e-01f,2.91259229e-01f,9.99560297e-01f,7.83326924e-01f,4.84776139e-01f,2.80778319e-01f,1.59362778e-01f,8.98785442e-02f,5.05891182e-02f,2.84566563e-02f,1.60038304e-02f,8.99987947e-03f,5.06105041e-03f,2.84604589e-03f,1.60045072e-03f,
-5.44021130e-01f,-6.12936914e-01f,-2.06835698e-02f,9.78552461e-01f,8.41470957e-01f,5.33168435e-01f,3.10983568e-01f,1.76892191e-01f,9.98334140e-02f,5.62044978e-02f,3.16175036e-02f,1.77818574e-02f,9.99983400e-03f,5.62338345e-03f,3.16227227e-03f,1.77827850e-03f,
-9.99990225e-01f,-9.72764567e-02f,-3.30574960e-01f,9.26681578e-01f,8.91207397e-01f,5.79875171e-01f,3.40877861e-01f,1.94365650e-01f,1.09778300e-01f,6.18181042e-02f,3.47780399e-02f,1.95598267e-02f,1.09997792e-02f,6.18571462e-03f,3.47849843e-03f,1.95610616e-03f,
-5.36572933e-01f,4.48342979e-01f,-6.07683420e-01f,8.45583618e-01f,9.32039082e-01f,6.24748647e-01f,3.70431304e-01f,2.11777672e-01f,1.19712204e-01f,6.74297586e-02f,3.79382223e-02f,2.13377345e-02f,1.19997123e-02f,6.74804440e-03f,3.79472389e-03f,2.13393359e-03f,
4.20167029e-01f,8.55880976e-01f,-8.24528456e-01f,7.37816215e-01f,9.63558197e-01f,6.67647004e-01f,3.99614304e-01f,2.29122713e-01f,1.29634142e-01f,7.30392784e-02f,4.10980321e-02f,2.31155735e-02f,1.29996343e-02f,7.31037185e-03f,4.11094911e-03f,2.31176103e-03f,
9.90607381e-01f,9.99823332e-01f,-9.59605396e-01f,6.06778562e-01f,9.85449731e-01f,7.08434701e-01f,4.28397775e-01f,2.46395305e-01f,1.39543116e-01f,7.86464810e-02f,4.42574248e-02f,2.48933397e-02f,1.39995432e-02f,7.87269697e-03f,4.42717411e-03f,2.48958869e-03f,
6.50287867e-01f,8.35838437e-01f,-9.99518692e-01f,4.56603259e-01f,9.97494996e-01f,7.46982634e-01f,4.56752867e-01f,2.63589978e-01f,1.49438128e-01f,8.42512026e-02f,4.74163815e-02f,2.66710296e-02f,1.49994381e-02f,8.43502022e-03f,4.74339863e-03f,2.66741589e-03f,
-2.87903309e-01f,4.14430231e-01f,-9.40310359e-01f,2.92027086e-01f,9.99573588e-01f,7.83169091e-01f,4.84651238e-01f,2.80701309e-01f,1.59318209e-01f,8.98532644e-02f,5.05748577e-02f,2.84486320e-02f,1.59993190e-02f,8.99733976e-03f,5.05962269e-03f,2.84524332e-03f,
-9.61397469e-01f,-1.34615138e-01f,-7.87851870e-01f,1.18240520e-01f,9.91664827e-01f,8.16879570e-01f,5.12064993e-01f,2.97723860e-01f,1.69182345e-01f,9.54524800e-02f,5.37328273e-02f,3.02261449e-02f,1.69991814e-02f,9.55965649e-03f,5.37584582e-03f,3.02307028e-03f,
-7.50987232e-01f,-6.42200708e-01f,-5.57262897e-01f,-5.92755191e-02f,9.73847628e-01f,8.48007560e-01f,5.38966715e-01f,3.14652264e-01f,1.79029569e-01f,1.01048686e-01f,5.68902642e-02f,3.20035629e-02f,1.79990288e-02f,1.01219704e-02f,5.69206895e-03f,3.20089748e-03f,
1.49877205e-01f,-9.52000856e-01f,-2.71410108e-01f,-2.34921798e-01f,9.46300089e-01f,8.76454532e-01f,5.65329552e-01f,3.31481189e-01f,1.88858896e-01f,1.06641680e-01f,6.00471310e-02f,3.37808803e-02f,1.89988576e-02f,1.06842816e-02f,6.00829115e-03f,3.37872445e-03f,
9.12945271e-01f,-9.68601942e-01f,4.13582884e-02f,-4.03158993e-01f,9.09297407e-01f,9.02130723e-01f,5.91127038e-01f,3.48205268e-01f,1.98669314e-01f,1.12231314e-01f,6.32033944e-02f,3.55580896e-02f,1.99986678e-02f,1.12465890e-02f,6.32451288e-03f,3.55655141e-03f,
8.36655617e-01f,-6.86891198e-01f,3.50024760e-01f,-5.58680534e-01f,8.63209307e-01f,9.24954832e-01f,6.16333544e-01f,3.64819258e-01f,2.08459899e-01f,1.17817394e-01f,6.63590282e-02f,3.73351872e-02f,2.09984574e-02f,1.18088927e-02f,6.64073415e-03f,3.73437814e-03f,
-8.85130931e-03f,-1.93630233e-01f,6.23979926e-01f,-6.96581721e-01f,8.08496356e-01f,9.44854796e-01f,6.40923738e-01f,3.81317884e-01f,2.18229622e-01f,1.23399742e-01f,6.95140064e-02f,3.91121693e-02f,2.19982266e-02f,1.23711927e-02f,6.95695449e-03f,3.91220488e-03f,
-8.46220434e-01f,3.59264523e-01f,8.36055279e-01f,-8.12512875e-01f,7.45705247e-01f,9.61767614e-01f,6.64873064e-01f,3.97695929e-01f,2.27977514e-01f,1.28978193e-01f,7.26682767e-02f,4.08890247e-02f,2.29979735e-02f,1.29334899e-02f,7.27317436e-03f,4.09003161e-03f,
-9.05578375e-01f,8.01513135e-01f,9.65219259e-01f,-9.02817786e-01f,6.75463140e-01f,9.75639880e-01f,6.88157499e-01f,4.13948208e-01f,2.37702623e-01f,1.34552568e-01f,7.58218244e-02f,4.26657498e-02f,2.39976961e-02f,1.34957815e-02f,7.58939330e-03f,4.26785741e-03f,
-1.32351756e-01f,9.96909976e-01f,9.98663187e-01f,-9.64648306e-01f,5.98472118e-01f,9.86427724e-01f,7.10753918e-01f,4.30069596e-01f,2.47403964e-01f,1.40122697e-01f,7.89746121e-02f,4.44423407e-02f,2.49973964e-02f,1.40580693e-02f,7.90561177e-03f,4.44568414e-03f,
7.62558460e-01f,8.85276794e-01f,9.33070183e-01f,-9.96054351e-01f,5.15501261e-01f,9.94096994e-01f,7.32639611e-01f,4.46054995e-01f,2.57080555e-01f,1.45688385e-01f,8.21266174e-02f,4.62187938e-02f,2.59970706e-02f,1.46203535e-02f,8.22182931e-03f,4.62350994e-03f,
9.56375957e-01f,5.00994205e-01f,7.74945021e-01f,-9.96045172e-01f,4.27379847e-01f,9.98623490e-01f,7.53792703e-01f,4.61899310e-01f,2.66731411e-01f,1.51249468e-01f,8.52777958e-02f,4.79951017e-02f,2.69967206e-02f,1.51826320e-02f,8.53804592e-03f,4.80133574e-03f,
2.70905793e-01f,-3.75856608e-02f,5.39968967e-01f,-9.64621305e-01f,3.34988207e-01f,9.99992907e-01f,7.74192095e-01f,4.77597594e-01f,2.76355654e-01f,1.56805754e-01f,8.84281173e-02f,4.97712530e-02f,2.79963426e-02f,1.57449059e-02f,8.85426160e-03f,4.97916201e-03f,
-6.63633883e-01f,-5.64589798e-01f,2.51445323e-01f,-9.02773678e-01f,2.39249229e-01f,9.98200953e-01f,7.93817401e-01f,4.93144840e-01f,2.85952210e-01f,1.62357092e-01f,9.15775672e-02f,5.15472479e-02f,2.89959367e-02f,1.63071752e-02f,9.17047635e-03f,5.15698735e-03f,
-9.88031626e-01f,-9.17709649e-01f,-6.20148405e-02f,-8.12452853e-01f,1.41120002e-01f,9.93253171e-01f,8.12648892e-01f,5.08536100e-01f,2.95520186e-01f,1.67903304e-01f,9.47260931e-02f,5.33230826e-02f,2.99955010e-02f,1.68694388e-02f,9.48669016e-03f,5.33481315e-03f,
-4.04037654e-01f,-9.88192797e-01f,-3.69325012e-01f,-6.96507812e-01f,4.15805206e-02f,9.85165298e-01f,8.30667794e-01f,5.23766637e-01f,3.05058628e-01f,1.73444211e-01f,9.78736654e-02f,5.50987460e-02f,3.09950355e-02f,1.74316969e-02f,9.80290305e-03f,5.51263802e-03f,
5.51426709e-01f,-7.54330218e-01f,-6.40009403e-01f,-5.58595300e-01f,-5.83741926e-02f,9.73962843e-01f,8.47856104e-01f,5.38831532e-01f,3.14566553e-01f,1.78979620e-01f,1.01020269e-01f,5.68742342e-02f,3.19945402e-02f,1.79939512e-02f,1.01191159e-02f,5.69046335e-03f,
9.99911845e-01f,-2.88147390e-01f,-8.47224355e-01f,-4.03064936e-01f,-1.57745644e-01f,9.59681332e-01f,8.64196658e-01f,5.53726017e-01f,3.24043006e-01f,1.84509367e-01f,1.04165860e-01f,5.86495437e-02f,3.29940096e-02f,1.85561981e-02f,1.04353270e-02f,5.86828869e-03f,
5.29082716e-01f,2.66779721e-01f,-9.70420420e-01f,-2.34822124e-01f,-2.55541205e-01f,9.42365825e-01f,8.79673064e-01f,5.68445385e-01f,3.33487093e-01f,1.90033287e-01f,1.07310407e-01f,6.04246669e-02f,3.39934528e-02f,1.91184394e-02f,1.07515370e-02f,6.04611309e-03f,
-4.28182662e-01f,7.39542127e-01f,-9.97380435e-01f,-5.91726787e-02f,-3.50783229e-01f,9.22071040e-01f,8.94269884e-01f,5.82984984e-01f,3.42897803e-01f,1.95551202e-01f,1.10453881e-01f,6.21996038e-02f,3.49928550e-02f,1.96806751e-02f,1.10677453e-02f,6.22393796e-03f,
-9.91778851e-01f,9.84540582e-01f,-9.25431013e-01f,1.18342586e-01f,-4.42520559e-01f,8.98861170e-01f,9.07972515e-01f,5.97340286e-01f,3.52274209e-01f,2.01062918e-01f,1.13596253e-01f,6.39743358e-02f,3.59922275e-02f,2.02429052e-02f,1.13839535e-02f,6.40176190e-03f,
-6.43538117e-01f,9.26318109e-01f,-7.61706948e-01f,2.92125374e-01f,-5.29836178e-01f,8.72809589e-01f,9.20767248e-01f,6.11506701e-01f,3.61615449e-01f,2.06568271e-01f,1.16737492e-01f,6.57488778e-02f,3.69915590e-02f,2.08051261e-02f,1.17001599e-02f,6.57958630e-03f,
2.96368569e-01f,5.82806170e-01f,-5.22444785e-01f,4.56694692e-01f,-6.11857831e-01f,8.43998730e-01f,9.32641268e-01f,6.25479698e-01f,3.70920479e-01f,2.12067112e-01f,1.19877554e-01f,6.75232038e-02f,3.79908569e-02f,2.13673431e-02f,1.20163653e-02f,6.75741071e-03f,
9.63795364e-01f,5.98003156e-02f,-2.31372014e-01f,6.06860459e-01f,-6.87766254e-01f,8.12519610e-01f,9.43582714e-01f,6.39254928e-01f,3.80188406e-01f,2.17559248e-01f,1.23016424e-01f,6.92973137e-02f,3.89901139e-02f,2.19295528e-02f,1.23325698e-02f,6.93523418e-03f,
7.45113134e-01f,-4.81621295e-01f,8.26458037e-02f,7.37885714e-01f,-7.56802499e-01f,7.78471708e-01f,9.53580678e-01f,6.52827978e-01f,3.89418334e-01f,2.23044485e-01f,1.26154065e-01f,7.10712075e-02f,3.99893373e-02f,2.24917568e-02f,1.26487734e-02f,7.11305765e-03f,
-1.58622667e-01f,-8.74714017e-01f,3.88467699e-01f,8.45638454e-01f,-8.18277061e-01f,7.41962790e-01f,9.62625206e-01f,6.66194677e-01f,3.98609310e-01f,2.28522688e-01f,1.29290432e-01f,7.28448778e-02f,4.09885161e-02f,2.30539497e-02f,1.29649751e-02f,7.29088066e-03f,
-9.16521549e-01f,-9.98410463e-01f,6.55764699e-01f,9.26720202e-01f,-8.71575892e-01f,7.03108132e-01f,9.70707119e-01f,6.79350674e-01f,4.07760441e-01f,2.33993664e-01f,1.32425532e-01f,7.46183172e-02f,4.19876575e-02f,2.36161388e-02f,1.32811759e-02f,7.46870413e-03f,
-8.31774771e-01f,-8.14614236e-01f,8.58030677e-01f,9.78573620e-01f,-9.16166008e-01f,6.62030637e-01f,9.77818429e-01f,6.92291796e-01f,4.16870773e-01f,2.39457220e-01f,1.35559291e-01f,7.63915181e-02f,4.29867506e-02f,2.41783205e-02f,1.35973748e-02f,7.64652714e-03f,
1.77019257e-02f,-3.79931390e-01f,9.75206196e-01f,9.99563396e-01f,-9.51602101e-01f,6.18860185e-01f,9.83951986e-01f,7.05014050e-01f,4.25939471e-01f,2.44913206e-01f,1.38691694e-01f,7.81644881e-02f,4.39858064e-02f,2.47404929e-02f,1.39135728e-02f,7.82434922e-03f,
8.50903511e-01f,1.71763569e-01f,9.95670974e-01f,9.89027262e-01f,-9.77530122e-01f,5.73733270e-01f,9.89101648e-01f,7.17513323e-01f,4.34965521e-01f,2.50361472e-01f,1.41822711e-01f,7.99371973e-02f,4.49848175e-02f,2.53026579e-02f,1.42297689e-02f,8.00217129e-03f,
9.01788354e-01f,6.70557022e-01f,9.17395473e-01f,9.47297752e-01f,-9.93690968e-01f,5.26792526e-01f,9.93262351e-01f,7.29785740e-01f,4.43948090e-01f,2.55801797e-01f,1.44952312e-01f,8.17096606e-02f,4.59837839e-02f,2.58648153e-02f,1.45459641e-02f,8.17999430e-03f,
1.23573124e-01f,9.62832689e-01f,7.48142362e-01f,8.75690997e-01f,-9.99923289e-01f,4.78186339e-01f,9.96429801e-01f,7.41827428e-01f,4.52886283e-01f,2.61234075e-01f,1.48080453e-01f,8.34818557e-02f,4.69827019e-02f,2.64269635e-02f,1.48621574e-02f,8.35781638e-03f,
-7.68254638e-01f,9.58573103e-01f,5.04697084e-01f,7.76465356e-01f,-9.96164620e-01f,4.28068399e-01f,9.98600960e-01f,7.53634512e-01f,4.61779177e-01f,2.66658038e-01f,1.51207119e-01f,8.52537975e-02f,4.79815714e-02f,2.69891042e-02f,1.51783489e-02f,8.53563752e-03f,
-9.53752637e-01f,6.59090102e-01f,2.11200655e-01f,6.52750373e-01f,-9.82452571e-01f,3.76597136e-01f,9.99773562e-01f,7.65203178e-01f,4.70625877e-01f,2.72073567e-01f,1.54332280e-01f,8.70254710e-02f,4.89803962e-02f,2.75512375e-02f,1.54945394e-02f,8.71345960e-03f,
-2.62374848e-01f,1.56619072e-01f,-1.03240460e-01f,5.08447945e-01f,-9.58924294e-01f,3.23935270e-01f,9.99946535e-01f,7.76529968e-01f,4.79425550e-01f,2.77480543e-01f,1.57455891e-01f,8.87968615e-02f,4.99791689e-02f,2.81133596e-02f,1.58107281e-02f,8.89127981e-03f,
6.70229197e-01f,-3.94086063e-01f,-4.07444149e-01f,3.48108500e-01f,-9.25814748e-01f,2.70249337e-01f,9.99119580e-01f,7.87611187e-01f,4.88177240e-01f,2.82878697e-01f,1.60577938e-01f,9.05679762e-02f,5.09778969e-02f,2.86754742e-02f,1.61269177e-02f,9.06910095e-03f,
9.86627579e-01f,-8.23421597e-01f,-6.71240151e-01f,1.76790684e-01f,-8.83454502e-01f,2.15709001e-01f,9.97293651e-01f,7.98443377e-01f,4.96880114e-01f,2.88267940e-01f,1.63698375e-01f,9.23388004e-02f,5.19765690e-02f,2.92375814e-02f,1.64431017e-02f,9.24692024e-03f,
3.95925164e-01f,-9.99157965e-01f,-8.68469954e-01f,-1.03020677e-04f,-8.32267344e-01f,1.60486728e-01f,9.94470477e-01f,8.09023023e-01f,5.05533338e-01f,2.93648034e-01f,1.66817173e-01f,9.41093415e-02f,5.29751927e-02f,2.97996756e-02f,1.67592876e-02f,9.42474138e-03f,
-5.58789074e-01f,-8.67171526e-01f,-9.79574919e-01f,-1.76993474e-01f,-7.72764444e-01f,1.04756832e-01f,9.90652919e-01f,8.19346905e-01f,5.14135957e-01f,2.99018890e-01f,1.69934288e-01f,9.58795771e-02f,5.39737605e-02f,3.03617641e-02f,1.70754679e-02f,9.60256159e-03f,
-9.99755144e-01f,-4.68111664e-01f,-9.93535519e-01f,-3.48301649e-01f,-7.05540299e-01f,4.86960001e-02f,9.85844791e-01f,8.29411685e-01f,5.22687256e-01f,3.04380238e-01f,1.73049718e-01f,9.76495072e-02f,5.49722798e-02f,3.09238415e-02f,1.73916500e-02f,9.78038087e-03f,
-5.21551013e-01f,7.51182064e-02f,-9.08967435e-01f,-5.08624554e-01f,-6.31266713e-01f,-7.51878507e-03f,9.80050862e-01f,8.39214146e-01f,5.31186223e-01f,3.09731960e-01f,1.76163420e-01f,9.94191393e-02f,5.59707358e-02f,3.14859077e-02f,1.77078284e-02f,9.95820016e-03f,
4.36164767e-01f,5.95211506e-01f,-7.34258294e-01f,-6.52905703e-01f,-5.50685287e-01f,-6.37097955e-02f,9.73276973e-01f,8.48751247e-01f,5.39632022e-01f,3.15073937e-01f,1.79275364e-01f,1.01188451e-01f,5.69691435e-02f,3.20479684e-02f,1.80240069e-02f,1.01360194e-02f,
9.92872655e-01f,9.31992829e-01f,-4.86733496e-01f,-7.76594579e-01f,-4.64602023e-01f,-1.19699396e-01f,9.65529919e-01f,8.58020008e-01f,5.48023939e-01f,3.20405900e-01f,1.82385504e-01f,1.02957435e-01f,5.79674877e-02f,3.26100141e-02f,1.83401816e-02f,1.03138378e-02f,
6.36738002e-01f,9.81735826e-01f,-1.90938011e-01f,-8.75790000e-01f,-3.73876572e-01f,-1.75310582e-01f,9.56817448e-01f,8.67017388e-01f,5.56361020e-01f,3.25727791e-01f,1.85493827e-01f,1.04726106e-01f,5.89657798e-02f,3.31720486e-02f,1.86563563e-02f,1.04916561e-02f,
-3.04810613e-01f,7.29123712e-01f,1.23790950e-01f,-9.47363734e-01f,-2.79415488e-01f,-2.30367512e-01f,9.47148204e-01f,8.75740528e-01f,5.64642429e-01f,3.31039310e-01f,1.88600287e-01f,1.06494442e-01f,5.99640086e-02f,3.37340795e-02f,1.89725272e-02f,1.06694745e-02f,
-9.66117799e-01f,2.51952261e-01f,4.26245421e-01f,-9.89057720e-01f,-1.82162598e-01f,-2.84696162e-01f,9.36531842e-01f,8.84186864e-01f,5.72867453e-01f,3.36340427e-01f,1.91704854e-01f,1.08262435e-01f,6.09621815e-02f,3.42960916e-02f,1.92886982e-02f,1.08472919e-02f,
-7.39180684e-01f,-3.02812874e-01f,6.86427653e-01f,-9.99557257e-01f,-8.30891207e-02f,-3.38124752e-01f,9.24979091e-01f,8.92353535e-01f,5.81035137e-01f,3.41630876e-01f,1.94807529e-01f,1.10030092e-01f,6.19602874e-02f,3.48580964e-02f,1.96048655e-02f,1.10251084e-02f,
1.67355701e-01f,-7.64320076e-01f,8.78538549e-01f,-9.78531301e-01f,1.68140903e-02f,-3.90484393e-01f,9.12501454e-01f,9.00238097e-01f,5.89144766e-01f,3.46910536e-01f,1.97908238e-01f,1.11797392e-01f,6.29583374e-02f,3.54200937e-02f,1.99210308e-02f,1.12029258e-02f};
namespace pg8 {
#define PG8_LAS __attribute__((address_space(3)))
typedef unsigned short bf16_t;
typedef short bf16x8 __attribute__((ext_vector_type(8)));
typedef float f32x4 __attribute__((ext_vector_type(4)));
typedef unsigned u32x4 __attribute__((ext_vector_type(4)));
constexpr int BM = 256, BK = 64, HALF = 128, HTB = HALF * BK * 2  , STAGE_BYTES = 8 * HTB, NXCD = 8, WGM = 8;

__host__ __device__ __forceinline__ int lds_byte(int r, int c) { const int st = (r >> 4) * 2 + (c >> 5), rr = r & 15, cc = c & 31, ob = rr * 64 + cc * 2; return st * 1024 + (ob ^ (((ob >> 9) & 1) << 5)); }
__host__ __device__ __forceinline__ void stage_rc(int b, int& R, int& C) { const int st = b / 1024, sb = b % 1024, swz = sb ^ (((sb >> 9) & 1) << 5); R = (st >> 1) * 16 + swz / 64; C = (st & 1) * 32 + (swz % 64) / 2; }
__host__ __device__ __forceinline__ int perm32(int rho) { const int n = rho >> 4, i = rho & 15; return 8 * (i >> 2) + 4 * n + (i & 3); }

struct Unit { int pm, pn; };
struct Gemm { const bf16_t* A; const bf16_t* Bt; int M, N, K; };
struct StaticOrder {
    int nM, nN, nwg, G, c, lat;
    __device__ __forceinline__ void init(int nM_, int nN_, int G_, int c_, int lat_) { nM = nM_; nN = nN_; nwg = nM_ * nN_; G = G_; c = c_; lat = lat_; }
    __device__ __forceinline__ bool next(int i, Unit& u) const {
        const long L = (long)i * G + c; if (L >= nwg) return false;
        int wgid = (int)L; { const int q = nwg / NXCD, r = nwg % NXCD, xcd = wgid % NXCD, off = wgid / NXCD; wgid = (xcd < r ? xcd * (q + 1) : r * (q + 1) + (xcd - r) * q) + off; }
        const int nig = WGM * nN, gid = wgid / nig, fm = gid * WGM, gsz = (nM - fm) < WGM ? (nM - fm) : WGM;
        const int pm = fm + ((wgid % nig) % gsz); u.pn = (wgid % nig) / gsz;
        u.pm = lat ? pm + pm / 16 + 1 : pm; return true;
    }
    __device__ __forceinline__ void a_ready(const Unit&) const {}
    __device__ __forceinline__ void done(const Unit&) const {}
};
__device__ __forceinline__ unsigned cvt_pk_bf16(float lo, float hi) { unsigned r; asm volatile("v_cvt_pk_bf16_f32 %0, %1, %2" : "=v"(r) : "v"(lo), "v"(hi)); return r; }
typedef float f32x2 __attribute__((ext_vector_type(2)));
template <int ACT  > struct EpiBf16 {
    static constexpr bool PERM = true, AFTER_DRAIN = false;
    bf16_t* O; int ldc;
    __device__ __forceinline__ void operator()(const f32x4 (&acc)[2][2][4][2], const Unit& u, int wr, int wc, int fr, int fq) const {
        const int row0 = u.pm * BM + wr * 64 + fr; const int col0 = u.pn * BM + wc * 32 + 8 * fq;
#pragma unroll
        for (int ai = 0; ai < 2; ++ai)
#pragma unroll
            for (int m = 0; m < 4; ++m) { bf16_t* rowp = O + (size_t)(row0 + ai * HALF + m * 16) * ldc + col0;
#pragma unroll
                for (int bj = 0; bj < 2; ++bj) { f32x4 v0 = acc[ai][bj][m][0], v1 = acc[ai][bj][m][1];
                    if (ACT == 2) { v0 = __builtin_elementwise_max(v0, (f32x4){0.f, 0.f, 0.f, 0.f}); v1 = __builtin_elementwise_max(v1, (f32x4){0.f, 0.f, 0.f, 0.f}); v0 = v0 * v0; v1 = v1 * v1; }
                    u32x4 w; w.x = cvt_pk_bf16(v0[0], v0[1]); w.y = cvt_pk_bf16(v0[2], v0[3]); w.z = cvt_pk_bf16(v1[0], v1[1]); w.w = cvt_pk_bf16(v1[2], v1[3]);
                    *(u32x4*)(rowp + bj * HALF) = w; } }
    }
};
struct EpiResid {
    static constexpr bool PERM = false, AFTER_DRAIN = false;
    float* xlat; float* xctx; const float* mod_l; int gidx; float alpha;
    __device__ __forceinline__ void operator()(const f32x4 (&acc)[2][2][4][2], const Unit& u, int wr, int wc, int fr, int fq) const {
        const int b = u.pm / 17, j = u.pm - b * 17;
        float* xt = (j == 0) ? xctx + (size_t)b * 256 * 1024 : xlat + ((size_t)b * 4096 + (size_t)(j - 1) * 256) * 1024;
        const float* gate = mod_l + (size_t)((j == 0) ? 8 : b) * 6144 + gidx * 1024;
        const int col0 = u.pn * BM + wc * 32 + 4 * fq;
        const int roff0 = (wr * 64 + fr) * 1024 + col0;
#pragma unroll
        for (int ai = 0; ai < 2; ++ai)
#pragma unroll
            for (int m = 0; m < 4; ++m) { float* rowp = xt + (roff0 + (ai * HALF + m * 16) * 1024);
#pragma unroll
                for (int bj = 0; bj < 2; ++bj)
#pragma unroll
                    for (int n = 0; n < 2; ++n) { const f32x4 gvv = *(const f32x4*)(gate + col0 + bj * HALF + n * 16); f32x4 x = *(const f32x4*)(rowp + bj * HALF + n * 16); x = x * alpha + gvv * acc[ai][bj][m][n]; *(f32x4*)(rowp + bj * HALF + n * 16) = x; }
                asm volatile("" ::: "memory"); }
    }
};
template <class Epi, class Sched, bool ALIGN_EPI = false, bool SP2 = false>
__device__ __forceinline__ void gemm_phase(PG8_LAS unsigned char* lds, const Gemm g, const Sched& S, const Epi& E) {
    int tid_l = threadIdx.x; asm volatile("" : "+v"(tid_l));
    const int tid = tid_l, wid = __builtin_amdgcn_readfirstlane(tid >> 6), lane = tid & 63, wr = wid >> 2, wc = wid & 3, fr = lane & 15, fq = lane >> 4;
    const int K = g.K, nt = K / BK;
    unsigned voffA[2], voffB[2];
#pragma unroll
    for (int i = 0; i < 2; ++i) { int R, C; stage_rc(tid * 16 + i * 8192, R, C); const int Rb = Epi::PERM ? ((R & ~31) + perm32(R & 31)) : R;
        voffA[i] = (unsigned)(R * K + C) * 2u; voffB[i] = (unsigned)(Rb * K + C) * 2u; }
    const size_t kstep = (size_t)(BK * 2);
    const size_t hstep = (size_t)HALF * K * 2;
    const size_t tstep = 2 * hstep;
    const unsigned ldsw = (unsigned)wid * 1024u;
    const int aoff = lds_byte(wr * 64 + fr, fq * 8), boff = lds_byte(wc * 32 + fr, fq * 8);
#define PG8_SA(b, h) (((b) * 2 + (h)) * HTB)
#define PG8_SB(b, h) ((4 + (b) * 2 + (h)) * HTB)
#define PG8_STAGE(bufoff, gbase, voff) do { _Pragma("unroll") for (int _i = 0; _i < 2; ++_i) \
        __builtin_amdgcn_global_load_lds((const unsigned*)((const char*)(gbase) + (voff)[_i]), (PG8_LAS unsigned*)(lds + (bufoff) + ldsw + _i * 8192), 16, 0, 0); } while (0)
#define PG8_LDA(dst, b, h) do { _Pragma("unroll") for (int m = 0; m < 4; ++m) _Pragma("unroll") for (int k = 0; k < 2; ++k) dst[m][k] = *(const PG8_LAS bf16x8*)(lds + PG8_SA(b, h) + aoff + m * 2048 + k * 1024); } while (0)
#define PG8_LDB(dst, b, h) do { _Pragma("unroll") for (int n = 0; n < 2; ++n) _Pragma("unroll") for (int k = 0; k < 2; ++k) dst[n][k] = *(const PG8_LAS bf16x8*)(lds + PG8_SB(b, h) + boff + n * 2048 + k * 1024); } while (0)
#define PG8_MMA(ai, bj, At, Bt) do { __builtin_amdgcn_s_setprio(1); _Pragma("unroll") for (int m = 0; m < 4; ++m) _Pragma("unroll") for (int n = 0; n < 2; ++n) _Pragma("unroll") for (int k = 0; k < 2; ++k) \
        acc[ai][bj][m][n] = __builtin_amdgcn_mfma_f32_16x16x32_bf16(Bt[n][k], At[m][k], acc[ai][bj][m][n], 0, 0, 0); __builtin_amdgcn_s_setprio(0); } while (0)
#define PG8_WAIT_V(n) asm volatile("s_waitcnt vmcnt(" #n ")" ::: "memory")
#define PG8_WAIT_L(n) asm volatile("s_waitcnt lgkmcnt(" #n ")" ::: "memory")
#define PG8_BAR __builtin_amdgcn_s_barrier()
#define PG8_SCHED __builtin_amdgcn_sched_barrier(0)
    Unit cur, nxt; int ui = 0;
    if (!S.next(0, cur)) return;
    f32x4 acc[2][2][4][2];
#pragma unroll
    for (int a = 0; a < 2; ++a)
#pragma unroll
        for (int b = 0; b < 2; ++b)
#pragma unroll
            for (int m = 0; m < 4; ++m)
#pragma unroll
                for (int n = 0; n < 2; ++n) acc[a][b][m][n] = (f32x4){0.f, 0.f, 0.f, 0.f};
    bf16x8 At[4][2], B0[2][2], B1[2][2];
    const char* cA = (const char*)g.A + (size_t)cur.pm * tstep; const char* cB = (const char*)g.Bt + (size_t)cur.pn * tstep;
    S.a_ready(cur);
    if constexpr (SP2) {
        PG8_STAGE(PG8_SB(0, 0), cB, voffB); PG8_STAGE(PG8_SB(0, 1), cB + hstep, voffB); PG8_STAGE(PG8_SA(0, 0), cA, voffA); PG8_STAGE(PG8_SA(0, 1), cA + hstep, voffA);
        if (wr == 1) PG8_BAR;
        PG8_WAIT_V(2); PG8_BAR;
        PG8_STAGE(PG8_SB(1, 0), cB + kstep, voffB); PG8_STAGE(PG8_SA(1, 0), cA + kstep, voffA); PG8_STAGE(PG8_SB(1, 1), cB + hstep + kstep, voffB);
        PG8_WAIT_V(6); PG8_BAR;
    } else {
        PG8_STAGE(PG8_SB(0, 0), cB, voffB); PG8_STAGE(PG8_SA(0, 0), cA, voffA); PG8_STAGE(PG8_SB(0, 1), cB + hstep, voffB); PG8_STAGE(PG8_SA(0, 1), cA + hstep, voffA);
        if (wr == 1) PG8_BAR;
        PG8_WAIT_V(4); PG8_BAR;
        PG8_STAGE(PG8_SB(1, 0), cB + kstep, voffB); PG8_STAGE(PG8_SA(1, 0), cA + kstep, voffA); PG8_STAGE(PG8_SB(1, 1), cB + hstep + kstep, voffB);
        PG8_WAIT_V(6); PG8_BAR;
    }
    for (;;) {
        const bool has_next = S.next(ui + 1, nxt);
        const char* nA = has_next ? (const char*)g.A + (size_t)nxt.pm * tstep : cA; const char* nB = has_next ? (const char*)g.Bt + (size_t)nxt.pn * tstep : cB;
        for (int t = 0; t < nt; t += 2) {
            const bool last = (t == nt - 2);
            const char* a1 = cA + (size_t)(t + 1) * kstep;
            const char* a2 = last ? nA : cA + (size_t)(t + 2) * kstep; const char* b2 = last ? nB : cB + (size_t)(t + 2) * kstep;
            const char* a3 = a2 + kstep; const char* b3 = b2 + kstep;
            if (last && has_next) S.a_ready(nxt);
            if constexpr (SP2) {
            PG8_LDB(B0, 0, 0); PG8_LDB(B1, 0, 1); PG8_SCHED; PG8_LDA(At, 0, 0); PG8_STAGE(PG8_SA(1, 1), a1 + hstep, voffA);
            PG8_WAIT_V(8); PG8_WAIT_L(0); PG8_BAR; PG8_MMA(0, 0, At, B0); PG8_MMA(0, 1, At, B1); PG8_BAR; PG8_SCHED;
            PG8_LDA(At, 0, 1); PG8_STAGE(PG8_SB(0, 0), b2, voffB); PG8_STAGE(PG8_SB(0, 1), b2 + hstep, voffB); PG8_STAGE(PG8_SA(0, 0), a2, voffA);
            PG8_WAIT_V(8); PG8_WAIT_L(0); PG8_BAR; PG8_MMA(1, 0, At, B0); PG8_MMA(1, 1, At, B1); PG8_BAR; PG8_SCHED;
            PG8_LDB(B0, 1, 0); PG8_LDB(B1, 1, 1); PG8_SCHED; PG8_LDA(At, 1, 0); PG8_STAGE(PG8_SA(0, 1), a2 + hstep, voffA);
            PG8_WAIT_V(8); PG8_WAIT_L(0); PG8_BAR; PG8_MMA(0, 0, At, B0); PG8_MMA(0, 1, At, B1); PG8_BAR; PG8_SCHED;
            PG8_LDA(At, 1, 1); PG8_STAGE(PG8_SB(1, 0), b3, voffB); PG8_STAGE(PG8_SB(1, 1), b3 + hstep, voffB); PG8_STAGE(PG8_SA(1, 0), a3, voffA);
            PG8_WAIT_V(8); PG8_WAIT_L(0); PG8_BAR; PG8_MMA(1, 0, At, B0); PG8_MMA(1, 1, At, B1); PG8_BAR; PG8_SCHED;
            } else {
            PG8_LDB(B0, 0, 0); PG8_SCHED; PG8_LDA(At, 0, 0); PG8_STAGE(PG8_SA(1, 1), a1 + hstep, voffA);
            PG8_WAIT_L(8); PG8_BAR; PG8_WAIT_L(0); PG8_MMA(0, 0, At, B0); PG8_BAR; PG8_SCHED;
            PG8_LDB(B1, 0, 1); PG8_STAGE(PG8_SB(0, 0), b2, voffB);
            PG8_BAR; PG8_WAIT_L(0); PG8_MMA(0, 1, At, B1); PG8_BAR;
            PG8_LDA(At, 0, 1); PG8_STAGE(PG8_SA(0, 0), a2, voffA);
            PG8_BAR; PG8_WAIT_L(0); PG8_MMA(1, 0, At, B0); PG8_BAR; PG8_SCHED;
            PG8_STAGE(PG8_SB(0, 1), b2 + hstep, voffB);
            PG8_WAIT_V(6); PG8_BAR; PG8_MMA(1, 1, At, B1); PG8_BAR;
            PG8_LDB(B0, 1, 0); PG8_SCHED; PG8_LDA(At, 1, 0); PG8_STAGE(PG8_SA(0, 1), a2 + hstep, voffA);
            PG8_WAIT_L(8); PG8_BAR; PG8_WAIT_L(0); PG8_MMA(0, 0, At, B0); PG8_BAR; PG8_SCHED;
            PG8_LDB(B1, 1, 1); PG8_STAGE(PG8_SB(1, 0), b3, voffB);
            PG8_BAR; PG8_WAIT_L(0); PG8_MMA(0, 1, At, B1); PG8_BAR;
            PG8_LDA(At, 1, 1); PG8_STAGE(PG8_SA(1, 0), a3, voffA);
            PG8_BAR; PG8_WAIT_L(0); PG8_MMA(1, 0, At, B0); PG8_BAR; PG8_SCHED;
            PG8_STAGE(PG8_SB(1, 1), b3 + hstep, voffB);
            PG8_WAIT_V(6); PG8_BAR; PG8_MMA(1, 1, At, B1); PG8_BAR;
            }
        }
        if constexpr (ALIGN_EPI) { if (wr == 0) PG8_BAR; }
        if constexpr (!Epi::AFTER_DRAIN) { E(acc, cur, wr, wc, fr, fq); S.done(cur); }
        if (!has_next) break;
#pragma unroll
        for (int a = 0; a < 2; ++a)
#pragma unroll
            for (int b = 0; b < 2; ++b)
#pragma unroll
                for (int m = 0; m < 4; ++m)
#pragma unroll
                    for (int n = 0; n < 2; ++n) acc[a][b][m][n] = (f32x4){0.f, 0.f, 0.f, 0.f};
        cur = nxt; cA = nA; cB = nB; ++ui;
        if constexpr (ALIGN_EPI) { if (wr == 1) PG8_BAR; }
    }
    PG8_WAIT_V(0);
    if constexpr (!ALIGN_EPI) { if (wr == 0) PG8_BAR; }
    PG8_BAR;
    if constexpr (Epi::AFTER_DRAIN) { E.fused(acc, cur, wr, wc, fr, fq, lds, wid, lane); S.done(cur); }
#undef PG8_SA
#undef PG8_SB
#undef PG8_STAGE
#undef PG8_LDA
#undef PG8_LDB
#undef PG8_MMA
#undef PG8_WAIT_V
#undef PG8_WAIT_L
#undef PG8_BAR
#undef PG8_SCHED
}
}
namespace attn_body {
using bf16=__hip_bfloat16;
using bf16x8=__attribute__((ext_vector_type(8)))short;
using s16x4=__attribute__((ext_vector_type(4)))short;
using f32x16=__attribute__((ext_vector_type(16)))float;
using u32x4=__attribute__((ext_vector_type(4)))unsigned;
constexpr int D=64,ZP=2304,OP=1024;
constexpr int NW=8,QBLK=32,QB=QBLK*NW,KVBLK=64;
constexpr int ATTN_UNIT_ROWS=QB;
__device__ __forceinline__ int crow(int r,int hi){return (r&3)+8*(r>>2)+4*hi;}
#define SBAR() __builtin_amdgcn_sched_barrier(0)
constexpr int NSLOT=3, SLOTB=8192;
constexpr int LDS_K=0, LDS_V=NSLOT*SLOTB, LDS_WS=2*NSLOT*SLOTB, LDS_OST=LDS_WS+NW*64*4, LDS_BYTES=LDS_OST+NW*4096;
constexpr float C2=0.125f*1.4426950408889634f;
__device__ __forceinline__ void glds16(const void*gsrc,unsigned lds_dst){unsigned keep;
  asm volatile("s_mov_b32 %0, m0\n\ts_mov_b32 m0, %2\n\ts_nop 0\n\tglobal_load_lds_dwordx4 %1, off\n\ts_mov_b32 m0, %0":"=&s"(keep):"v"(gsrc),"s"(lds_dst):"memory");}
__device__ __forceinline__ float max3f(float a,float b,float c){float r;asm("v_max3_f32 %0, %1, %2, %3":"=v"(r):"v"(a),"v"(b),"v"(c));return r;}
__device__ __forceinline__ float max2f(float a,float b){float r;asm("v_max_f32_e32 %0, %1, %2":"=v"(r):"v"(a),"v"(b));return r;}
__device__ __forceinline__ float fadd_s(float a,float b){float r;asm("v_add_f32_e32 %0, %1, %2":"=v"(r):"v"(a),"v"(b));return r;}
__device__ __forceinline__ float fsub_s(float a,float b){float r;asm("v_sub_f32_e32 %0, %1, %2":"=v"(r):"v"(a),"v"(b));return r;}
typedef float f32x2_t __attribute__((ext_vector_type(2))); typedef __bf16 bf16x2_t __attribute__((ext_vector_type(2)));
__device__ __forceinline__ unsigned cvtpk_s(float lo,float hi){f32x2_t v={lo,hi};bf16x2_t b=__builtin_convertvector(v,bf16x2_t);return __builtin_bit_cast(unsigned,b);}
#define WAIT_BAR(N) asm volatile("s_waitcnt vmcnt(" #N ") lgkmcnt(0)\n\ts_barrier":::"memory")

__device__ __forceinline__ void qkt(f32x16&p0,f32x16&p1,const char*Kslot,const bf16x8*qr,const f32x16&negm,int r32,int hi){
  const char*kb=Kslot+hi*1024+r32*16;
  #pragma unroll
  for(int d0=0;d0<4;++d0){
    const bf16x8 b0=*reinterpret_cast<const bf16x8*>(kb+d0*2048);
    const bf16x8 b1=*reinterpret_cast<const bf16x8*>(kb+d0*2048+512);
    if(d0==0){p0=__builtin_amdgcn_mfma_f32_32x32x16_bf16(b0,qr[0],negm,0,0,0);p1=__builtin_amdgcn_mfma_f32_32x32x16_bf16(b1,qr[0],negm,0,0,0);}
    else{p0=__builtin_amdgcn_mfma_f32_32x32x16_bf16(b0,qr[d0],p0,0,0,0);p1=__builtin_amdgcn_mfma_f32_32x32x16_bf16(b1,qr[d0],p1,0,0,0);}}
}
typedef __attribute__((address_space(3))) const char* lds_cptr;
typedef short v4i16_t __attribute__((ext_vector_type(4)));
__device__ __forceinline__ void kload8(bf16x8*kf,lds_cptr kp){
  kf[0]=*(const __attribute__((address_space(3))) bf16x8*)(kp);      kf[1]=*(const __attribute__((address_space(3))) bf16x8*)(kp+512);
  kf[2]=*(const __attribute__((address_space(3))) bf16x8*)(kp+2048); kf[3]=*(const __attribute__((address_space(3))) bf16x8*)(kp+2560);
  kf[4]=*(const __attribute__((address_space(3))) bf16x8*)(kp+4096); kf[5]=*(const __attribute__((address_space(3))) bf16x8*)(kp+4608);
  kf[6]=*(const __attribute__((address_space(3))) bf16x8*)(kp+6144); kf[7]=*(const __attribute__((address_space(3))) bf16x8*)(kp+6656);
}
__device__ __forceinline__ void kload2(bf16x8*kf,lds_cptr kp,int j){ kf[2*j]=*(const __attribute__((address_space(3))) bf16x8*)(kp+j*2048); kf[2*j+1]=*(const __attribute__((address_space(3))) bf16x8*)(kp+j*2048+512); }
__device__ __forceinline__ s16x4 vtr(lds_cptr p){ return __builtin_bit_cast(s16x4,__builtin_amdgcn_ds_read_tr16_b64_v4i16((__attribute__((address_space(3))) v4i16_t*)p)); }
__device__ __forceinline__ float rowmax(const f32x16&p0,const f32x16&p1){
  float a=max3f(p0[0],p0[1],p1[0]),b=max3f(p0[2],p0[3],p1[1]);a=max3f(a,p1[2],p1[3]);
  #pragma unroll
  for(int r=4;r<16;r+=4){a=max3f(a,p0[r],p0[r+1]);b=max3f(b,p0[r+2],p0[r+3]);a=max3f(a,p1[r],p1[r+1]);b=max3f(b,p1[r+2],p1[r+3]);}
  const float m=max2f(a,b);
  auto rr=__builtin_amdgcn_permlane32_swap(__float_as_uint(m),__float_as_uint(m),false,false);
  return max2f(__uint_as_float(rr[0]),__uint_as_float(rr[1]));
}
__device__ __forceinline__ void pv(f32x16*o,int vb,bf16x8 pa0,bf16x8 pa1,bf16x8 pa2,bf16x8 pa3){
  #pragma unroll
  for(int d0=0;d0<2;++d0){s16x4 lo[4],hi[4];
    #pragma unroll
    for(int ks=0;ks<4;++ks){
      asm volatile("ds_read_b64_tr_b16 %0,%1 offset:%c2":"=&v"(lo[ks]):"v"(vb),"i"(d0*4096+ks*1024):"memory");
      asm volatile("ds_read_b64_tr_b16 %0,%1 offset:%c2":"=&v"(hi[ks]):"v"(vb),"i"(d0*4096+ks*1024+512):"memory");}
    asm volatile("s_waitcnt lgkmcnt(0)":::"memory");SBAR();
    #define PK(k) (bf16x8){lo[k][0],lo[k][1],lo[k][2],lo[k][3],hi[k][0],hi[k][1],hi[k][2],hi[k][3]}
    o[d0]=__builtin_amdgcn_mfma_f32_32x32x16_bf16(pa0,PK(0),o[d0],0,0,0);
    o[d0]=__builtin_amdgcn_mfma_f32_32x32x16_bf16(pa1,PK(1),o[d0],0,0,0);
    o[d0]=__builtin_amdgcn_mfma_f32_32x32x16_bf16(pa2,PK(2),o[d0],0,0,0);
    o[d0]=__builtin_amdgcn_mfma_f32_32x32x16_bf16(pa3,PK(3),o[d0],0,0,0);
    #undef PK
  }
}

#ifndef ATTN_STORE16
#define ATTN_STORE16(p,v) (*(u32x4*)(p)=(v))
#endif
template<int THRL> __device__ __forceinline__ void attn_unit(const bf16*Q0,const bf16*__restrict__ Kh,const bf16*__restrict__ Vh,bf16*O0,const int NT,char*shm){
  int tid_l=threadIdx.x; asm volatile("":"+v"(tid_l)); const int tid=tid_l,lane=tid&63,r32=lane&31,hi=lane>>5; const int wid=__builtin_amdgcn_readfirstlane(tid>>6);
  const bf16*Qw=Q0+(long)(wid*QBLK)*ZP;
  const unsigned lds0=(unsigned)(uintptr_t)shm;
  float*wsf=(float*)(shm+LDS_WS)+wid*64;
  const bf16*ksrc=Kh+(long)lane*ZP+wid*8;
  const bf16*vsrc=Vh+(long)(16*(wid&3)+(lane>>2))*ZP+(wid>>2)*32+(lane&3)*8;
  const unsigned kdst=lds0+LDS_K+wid*1024, vdst=lds0+LDS_V+wid*1024;
  #define DMA_K(t,slot) glds16(ksrc+(long)(t)*KVBLK*ZP,(unsigned)__builtin_amdgcn_readfirstlane(kdst+(slot)))
  #define DMA_V(t,slot) glds16(vsrc+(long)(t)*KVBLK*ZP,(unsigned)__builtin_amdgcn_readfirstlane(vdst+(slot)))
  const int vb0=(int)(lds0+LDS_V)+((lane>>4)&1)*32+(lane&3)*8+(4*hi+((lane&15)>>2))*64;
  const char*Kbase=shm+LDS_K; bf16x8 kf[8];
  const lds_cptr shm3=(lds_cptr)shm; const lds_cptr kp0=shm3+LDS_K+hi*1024+r32*16; const lds_cptr vp0=shm3+LDS_V+((lane>>4)&1)*32+(lane&3)*8+(4*hi+((lane&15)>>2))*64;
  DMA_K(0,0);DMA_V(0,0);DMA_K(1,SLOTB);
  bf16x8 qr[4];
  #pragma unroll
  for(int d0=0;d0<4;++d0)qr[d0]=*reinterpret_cast<const bf16x8*>(&Qw[(long)r32*ZP+d0*16+hi*8]);
  float mhat=0.f,l_reg=0.f;f32x16 o[2];o[0]=f32x16{};o[1]=f32x16{};f32x16 negm=f32x16{};asm volatile("":"+v"(negm));
  #define CMASK(P0,P1,t) do{}while(0)
  bool resc=false;
  #define START(P0,P1) do{ const float rm=rowmax(P0,P1); resc=false; \
    { const float dl=rm; mhat=fadd_s(mhat,dl); \
      _Pragma("unroll") for(int r=0;r<16;++r){P0[r]=fsub_s(P0[r],dl);P1[r]=fsub_s(P1[r],dl);} \
      _Pragma("unroll") for(int r=0;r<16;++r)negm[r]=-mhat; asm volatile("":"+v"(negm)); } \
    _Pragma("unroll") for(int r=0;r<16;++r)P0[r]=__builtin_amdgcn_exp2f(P0[r]); }while(0)
  #define RESC() do{ if(resc){ asm volatile("s_waitcnt lgkmcnt(0)":::"memory"); \
      _Pragma("unroll") for(int d_=0;d_<2;++d_) _Pragma("unroll") for(int r=0;r<16;++r)o[d_][r]*=wsf[crow(r,hi)]; } }while(0)
  f32x16 pA0,pA1,pB0,pB1;
  int sl_prev=0,sl_cur=0,sl_next=SLOTB;
  #define ROT() do{sl_prev=sl_cur;sl_cur=sl_next;sl_next=(sl_next==(NSLOT-1)*SLOTB)?0:sl_next+SLOTB;}while(0)
  DMA_K(2,2*SLOTB);
  WAIT_BAR(3);
  qkt(pA0,pA1,Kbase,qr,negm,r32,hi);asm volatile("s_nop 15\n\ts_nop 7":"+v"(pA0),"+v"(pA1));CMASK(pA0,pA1,0);
  START(pA0,pA1);
  _Pragma("unroll") for(int r=0;r<16;++r)pA1[r]=__builtin_amdgcn_exp2f(pA1[r]);
  WAIT_BAR(0);
  DMA_K(3,0);DMA_V(1,SLOTB);
  ROT();
  kload8(kf,kp0+sl_cur);
  WAIT_BAR(2);
  s16x4 vlo[8],vhi[8]; u32x4 pw0,pw1,pw2,pw3;
  #define PKW(P,B) cvtpk_s(P[B],P[B+1])
  #define PAF(k) __builtin_bit_cast(bf16x8,pw##k)
  #define VFR(i) (bf16x8){vlo[i][0],vlo[i][1],vlo[i][2],vlo[i][3],vhi[i][0],vhi[i][1],vhi[i][2],vhi[i][3]}
  #define PIN(x) asm volatile("":"+v"(x))
  #define MX3(a,b,c) __builtin_fmaxf(__builtin_fmaxf((a),(b)),(c))
  #define GAPA(MF,A0,A1,A2,A3,W0,W1,PW) do{ MF; sacc+=A0; sacc+=A1; sacc+=A2; sacc+=A3; PIN(sacc); W0; W1; PIN(PW); SBAR(); }while(0)
  #define EX(v) __builtin_amdgcn_exp2f(v)
  #define GAPB(MF,X,B) do{ MF; X[B]=EX(X[B]); X[B+1]=EX(X[B+1]); X[B+2]=EX(X[B+2]); X[B+3]=EX(X[B+3]); PIN(X); SBAR(); }while(0)
  #define VRD(i) do{ vlo[i]=vtr(vp_+(((i)>>2)*4096+((i)&3)*1024)); vhi[i]=vtr(vp_+(((i)>>2)*4096+((i)&3)*1024+512)); }while(0)
  #define KRD(G,j) do{ if(G){ kload2(kf,kp0+sl_next,j); SBAR(); } }while(0)
  #define STEP(C0,C1,P0,P1,t,GK,GV,GL) do{ SBAR(); \
    const lds_cptr vp_=vp0+sl_prev; \
    VRD(0); SBAR(); float sacc=(P0[0]+P0[1]); \
    GAPA(C0=__builtin_amdgcn_mfma_f32_32x32x16_bf16(kf[0],qr[0],negm,0,0,0), P0[2],P0[3],P0[4],P0[5],     pw0[0]=PKW(P0,0), pw0[1]=PKW(P0,2), pw0); \
    VRD(4); SBAR(); GAPA(C1=__builtin_amdgcn_mfma_f32_32x32x16_bf16(kf[1],qr[0],negm,0,0,0), P0[6],P0[7],P0[8],P0[9],     pw0[2]=PKW(P0,4), pw0[3]=PKW(P0,6), pw0); \
    VRD(1); SBAR(); GAPA(C0=__builtin_amdgcn_mfma_f32_32x32x16_bf16(kf[2],qr[1],C0,0,0,0),   P0[10],P0[11],P0[12],P0[13], pw1[0]=PKW(P0,8), pw1[1]=PKW(P0,10), pw1); \
    VRD(5); SBAR(); GAPA(C1=__builtin_amdgcn_mfma_f32_32x32x16_bf16(kf[3],qr[1],C1,0,0,0),   P0[14],P0[15],P1[0],P1[1],   pw1[2]=PKW(P0,12),pw1[3]=PKW(P0,14), pw1); \
    VRD(2); SBAR(); GAPA(C0=__builtin_amdgcn_mfma_f32_32x32x16_bf16(kf[4],qr[2],C0,0,0,0),   P1[2],P1[3],P1[4],P1[5],     pw2[0]=PKW(P1,0), pw2[1]=PKW(P1,2), pw2); \
    VRD(6); SBAR(); GAPA(C1=__builtin_amdgcn_mfma_f32_32x32x16_bf16(kf[5],qr[2],C1,0,0,0),   P1[6],P1[7],P1[8],P1[9],     pw2[2]=PKW(P1,4), pw2[3]=PKW(P1,6), pw2); \
    VRD(3); SBAR(); GAPA(C0=__builtin_amdgcn_mfma_f32_32x32x16_bf16(kf[6],qr[3],C0,0,0,0),   P1[10],P1[11],P1[12],P1[13], pw3[0]=PKW(P1,8), pw3[1]=PKW(P1,10), pw3); \
    VRD(7); SBAR(); GAPA(C1=__builtin_amdgcn_mfma_f32_32x32x16_bf16(kf[7],qr[3],C1,0,0,0),   P1[14],P1[15],0.f,0.f,       pw3[2]=PKW(P1,12),pw3[3]=PKW(P1,14), pw3); \
    l_reg+=sacc; \
    if(GK){DMA_K((t)+3,sl_cur);} if(GV){DMA_V((t)+1,sl_next);} \
    CMASK(C0,C1,t); \
    { float a=MX3(C0[0],C0[1],C1[0]),b=MX3(C0[2],C0[3],C1[1]); a=MX3(a,C1[2],C1[3]); \
      _Pragma("unroll") for(int r=4;r<16;r+=4){a=MX3(a,C0[r],C0[r+1]);b=MX3(b,C0[r+2],C0[r+3]);a=MX3(a,C1[r],C1[r+1]);b=MX3(b,C1[r+2],C1[r+3]);} \
      float rm=__builtin_fmaxf(a,b); { auto rr=__builtin_amdgcn_permlane32_swap(__float_as_uint(rm),__float_as_uint(rm),false,false); rm=__builtin_fmaxf(__uint_as_float(rr[0]),__uint_as_float(rr[1])); } \
      resc=false; \
      if(__builtin_expect(__any(rm>(float)THRL),0)){ const float dl=__builtin_fmaxf(rm,0.f); mhat+=dl; \
        _Pragma("unroll") for(int r=0;r<16;++r){C0[r]-=dl;C1[r]-=dl;} \
        _Pragma("unroll") for(int r=0;r<16;++r)negm[r]=-mhat; asm volatile("":"+v"(negm)); \
        const float f=__builtin_amdgcn_exp2f(-dl); l_reg*=f; if(hi==0)wsf[r32]=f; resc=true; } } \
    SBAR(); \
    GAPB(o[0]=__builtin_amdgcn_mfma_f32_32x32x16_bf16(PAF(0),VFR(0),o[0],0,0,0), C0,0); \
    GAPB(o[1]=__builtin_amdgcn_mfma_f32_32x32x16_bf16(PAF(0),VFR(4),o[1],0,0,0), C0,4); \
    KRD(GL,0); GAPB(o[0]=__builtin_amdgcn_mfma_f32_32x32x16_bf16(PAF(1),VFR(1),o[0],0,0,0), C0,8); \
    KRD(GL,1); GAPB(o[1]=__builtin_amdgcn_mfma_f32_32x32x16_bf16(PAF(1),VFR(5),o[1],0,0,0), C0,12); \
    KRD(GL,2); GAPB(o[0]=__builtin_amdgcn_mfma_f32_32x32x16_bf16(PAF(2),VFR(2),o[0],0,0,0), C1,0); \
    KRD(GL,3); GAPB(o[1]=__builtin_amdgcn_mfma_f32_32x32x16_bf16(PAF(2),VFR(6),o[1],0,0,0), C1,4); \
    GAPB(o[0]=__builtin_amdgcn_mfma_f32_32x32x16_bf16(PAF(3),VFR(3),o[0],0,0,0), C1,8); \
    GAPB(o[1]=__builtin_amdgcn_mfma_f32_32x32x16_bf16(PAF(3),VFR(7),o[1],0,0,0), C1,12); \
    }while(0)
  int t=1;
  #undef CMASK
  #define CMASK(P0,P1,t) do{}while(0)
  for(;t+5<NT;t+=2){
    STEP(pB0,pB1,pA0,pA1,t,true,true,true);     WAIT_BAR(2); RESC(); ROT();
    STEP(pA0,pA1,pB0,pB1,t+1,true,true,true);   WAIT_BAR(2); RESC(); ROT();
  }
  #undef CMASK
  #define CMASK(P0,P1,t) do{}while(0)
  #define ENDW(tt) do{ if((tt)+3<NT){WAIT_BAR(2);} else if((tt)+2<NT){WAIT_BAR(1);} else {WAIT_BAR(0);} }while(0)
  for(;t+1<NT;t+=2){
    STEP(pB0,pB1,pA0,pA1,t,(t+3<NT),(t+1<NT),(t+1<NT));       ENDW(t);   RESC(); ROT();
    STEP(pA0,pA1,pB0,pB1,t+1,(t+4<NT),(t+2<NT),(t+2<NT));     ENDW(t+1); RESC(); ROT();
  }
  STEP(pB0,pB1,pA0,pA1,NT-1,false,false,false); RESC();
  { float sacc=pB0[0]+pB0[1]; _Pragma("unroll") for(int r=2;r<16;++r)sacc+=pB0[r]; _Pragma("unroll") for(int r=0;r<16;++r)sacc+=pB1[r]; l_reg+=sacc;
    pw0=(u32x4){PKW(pB0,0),PKW(pB0,2),PKW(pB0,4),PKW(pB0,6)};pw1=(u32x4){PKW(pB0,8),PKW(pB0,10),PKW(pB0,12),PKW(pB0,14)};pw2=(u32x4){PKW(pB1,0),PKW(pB1,2),PKW(pB1,4),PKW(pB1,6)};pw3=(u32x4){PKW(pB1,8),PKW(pB1,10),PKW(pB1,12),PKW(pB1,14)};
    SBAR(); pv(o,vb0+sl_cur,PAF(0),PAF(1),PAF(2),PAF(3)); }
  #undef PKW
  #undef PAF
  #undef VFR
  #undef PIN
  #undef MX3
  #undef GAPA
  #undef GAPB
  #undef EX
  #undef VRD
  #undef KRD
  #undef STEP
  #undef ENDW
  {auto rr=__builtin_amdgcn_permlane32_swap(__float_as_uint(l_reg),__float_as_uint(l_reg),false,false);l_reg=__uint_as_float(rr[0])+__uint_as_float(rr[1]);}
  if(hi==0)wsf[32+r32]=l_reg;asm volatile("s_waitcnt lgkmcnt(0)":::"memory");
  float rli[16];
  #pragma unroll
  for(int r=0;r<16;++r)rli[r]=__builtin_amdgcn_rcpf(wsf[32+crow(r,hi)]);
  bf16*Ow=O0+(long)(wid*QBLK)*OP;
  { bf16*stg=(bf16*)(shm+LDS_OST)+wid*2048;
    #pragma unroll
    for(int r=0;r<16;++r){const int orow=crow(r,hi);
      #pragma unroll
      for(int d0=0;d0<2;++d0)stg[orow*64+d0*32+r32]=__float2bfloat16(o[d0][r]*rli[r]);}
    asm volatile("s_waitcnt lgkmcnt(0)":::"memory");
    #pragma unroll
    for(int i=0;i<4;++i){const int row=i*8+(lane>>3),ch=lane&7; const u32x4 v=*(const u32x4*)(stg+row*64+ch*8); ATTN_STORE16(Ow+(long)row*OP+ch*8,v);} }
  asm volatile("s_waitcnt lgkmcnt(0)\n\ts_barrier":::"memory");
  #undef DMA_K
  #undef DMA_V
  #undef CMASK
  #undef START
  #undef RESC
  #undef ROT
}
constexpr int ATTN_LDS_BYTES=LDS_BYTES;
#undef SBAR
#undef WAIT_BAR
}
#define GAS __attribute__((address_space(1)))
#define LAS __attribute__((address_space(3)))
typedef unsigned short bf16r;
typedef unsigned v4u __attribute__((ext_vector_type(4)));
typedef float f32x4 __attribute__((ext_vector_type(4)));
constexpr int NWAVES = 8;
constexpr int DM = 1024, NB = 8, SEQL = 4096, CTXL = 256, TPB = SEQL + CTXL  , MT = NB * TPB  ;
constexpr int FF = 4096, ZA = 2304, ZC = 3072, NMOD = 6144;
constexpr float LN_EPS = 1e-6f;
constexpr float DN_ALPHA = 1.6817928305074290f;
constexpr size_t MiB = 1u << 20;
constexpr size_t WS_MOD = 0;
constexpr size_t WS_XCTX = 1 * MiB;
constexpr size_t WS_WINA = 10 * MiB;
constexpr size_t WS_WOUTA = 19 * MiB;
constexpr size_t WS_WINC = 23 * MiB;
constexpr size_t WS_WOUTC = 35 * MiB;
constexpr size_t WS_W1 = 39 * MiB;
constexpr size_t WS_W2 = 71 * MiB;
constexpr size_t WS_H = 104 * MiB;
constexpr size_t WS_O = 172 * MiB;
constexpr size_t WS_Z = 240 * MiB;
constexpr size_t WS_DS = 393 * MiB;
constexpr size_t WS_HID = 172 * MiB;
constexpr size_t WS_END = 461 * MiB;
constexpr int LDS_BYTES = 147456;

__device__ __forceinline__ unsigned f2bf(float f) { unsigned u = __builtin_bit_cast(unsigned, f); return (u + 0x7fffu + ((u >> 16) & 1u)) >> 16; }
__device__ __forceinline__ unsigned pk2(float lo, float hi) { return f2bf(lo) | (f2bf(hi) << 16); }
__device__ __forceinline__ float bflo(unsigned w) { return __builtin_bit_cast(float, w << 16); }
__device__ __forceinline__ float bfhi(unsigned w) { return __builtin_bit_cast(float, w & 0xffff0000u); }
#define LDS_WAIT() asm volatile("s_waitcnt lgkmcnt(0)" ::: "memory")
__device__ __forceinline__ float wave_sum(float v) {
#pragma unroll
    for (int o = 1; o < 64; o <<= 1) v += __shfl_xor(v, o);
    return v;
}
__device__ __forceinline__ void p0_transpose_item(const float* W, int K, int N, bf16r* WT, LAS float* scr, int item, int lane) {
    const int nblk = N / 32, kb = item / nblk, nb = item % nblk, k0 = 64 * kb, n0 = 32 * nb;
#pragma unroll 8
    for (int i = 0; i < 32; ++i) { const int kk = 2 * i + (lane >> 5); scr[kk * 33 + (lane & 31)] = W[(size_t)(k0 + kk) * N + n0 + (lane & 31)]; }
    LDS_WAIT(); asm volatile("" ::: "memory");
    const int c = lane & 7;
#pragma unroll
    for (int j = 0; j < 4; ++j) { const int n = (lane >> 3) + 8 * j; const LAS float* s = scr + (8 * c) * 33 + n;
        v4u o; o.x = pk2(s[0 * 33], s[1 * 33]); o.y = pk2(s[2 * 33], s[3 * 33]); o.z = pk2(s[4 * 33], s[5 * 33]); o.w = pk2(s[6 * 33], s[7 * 33]);
        *(v4u*)(WT + (size_t)(n0 + n) * K + k0 + 8 * c) = o; }
    LDS_WAIT(); asm volatile("" ::: "memory");
}

#define PHASE_IDS() int tid_l = threadIdx.x; asm volatile("" : "+v"(tid_l)); const int lane = tid_l & 63, wave = __builtin_amdgcn_readfirstlane(tid_l >> 6); const int gw = vcu * NWAVES + wave, NGW = G * NWAVES; (void)lane; (void)gw; (void)NGW
struct Args { const float* in[20]; float* out; unsigned char* ws; };
enum { I_X = 0, I_C, I_CTX, I_CCTX, I_ADAW, I_ADAB, I_AWIN, I_AWOUT, I_DLAM, I_DSUBG, I_QNG, I_KNG, I_CWIN, I_CW, I_CB, I_CWOUT, I_W1, I_W2, I_LNG, I_LNB };

template <bool INIT>
__device__ __forceinline__ void row_pass(int vcu, int G, const float* xin, const float* ctxin, float* xlat, float* xctx, bf16r* H,
                                         const float* lng, const float* lnb, const float* modn, int shidx, bool lat_only) {
    PHASE_IDS();
    for (int m = gw; m < MT; m += NGW) {
        const int b = m / TPB, r = m - b * TPB; const bool ctx = r < CTXL;
        if (lat_only && ctx) continue;
        float* xrow = ctx ? xctx + ((size_t)b * CTXL + r) * DM : xlat + ((size_t)b * SEQL + (r - CTXL)) * DM;
        const float* src = INIT ? (ctx ? ctxin + ((size_t)b * CTXL + r) * DM : xin + ((size_t)b * SEQL + (r - CTXL)) * DM) : xrow;
        f32x4 v[4];
#pragma unroll
        for (int j = 0; j < 4; ++j) v[j] = ((const f32x4*)src)[lane + 64 * j];
        if (!INIT) {
            float s = 0.f;
#pragma unroll
            for (int j = 0; j < 4; ++j) s += (v[j].x + v[j].y) + (v[j].z + v[j].w);
            const float mean = wave_sum(s) * (1.f / DM); float s2 = 0.f;
#pragma unroll
            for (int j = 0; j < 4; ++j) { v[j] = v[j] - mean; s2 += (v[j].x * v[j].x + v[j].y * v[j].y) + (v[j].z * v[j].z + v[j].w * v[j].w); }
            const float rstd = 1.f / sqrtf(wave_sum(s2) * (1.f / DM) + LN_EPS);
#pragma unroll
            for (int j = 0; j < 4; ++j) { const f32x4 g = ((const f32x4*)lng)[lane + 64 * j], bb = ((const f32x4*)lnb)[lane + 64 * j]; v[j] = v[j] * rstd * g + bb; }
        }
#pragma unroll
        for (int j = 0; j < 4; ++j) ((f32x4*)xrow)[lane + 64 * j] = v[j];
        if (modn) {
            const float* sh = modn + (size_t)(ctx ? 8 : b) * NMOD + shidx * DM; const float* sc = sh + DM;
            unsigned long long* o8 = (unsigned long long*)(H + (size_t)m * DM) + lane;
#pragma unroll
            for (int j = 0; j < 4; ++j) { const f32x4 a = ((const f32x4*)sh)[lane + 64 * j], c = ((const f32x4*)sc)[lane + 64 * j]; const f32x4 h = v[j] * (c + 1.0f) + a;
                o8[64 * j] = (unsigned long long)pk2(h.x, h.y) | ((unsigned long long)pk2(h.z, h.w) << 32); }
        }
    }
}

__device__ __forceinline__ void postproj_pass(int vcu, int G, bf16r* Z, const float* qng, const float* kng) {
    PHASE_IDS();
    const int half = lane >> 5, p = lane & 31, axis = p >> 4, f = p & 15;
    const float C2 = 0.125f * 1.4426950408889634f;
    for (int m = gw; m < MT; m += NGW) {
        const int b = m / TPB, r = m - b * TPB; const bool lat = r >= CTXL; const int t = r - CTXL;
        const int pos = axis == 0 ? (t >> 6) : (t & 63);
        float cs = 1.f, sn = 0.f; if (lat) { cs = ROPE_COS[pos * 16 + f]; sn = ROPE_SIN[pos * 16 + f]; }
        bf16r* zr = Z + (size_t)m * ZA;
#pragma unroll 1
        for (int it = 0; it < 13; ++it) {
            const int s = 2 * it + half;
            const int base = s < 16 ? s * 64 : (s < 24 ? 1536 + (s - 16) * 64 : 2048 + (s - 24) * 64);
            const bool isq = (s < 8) || (s >= 16 && s < 24); const bool nrm = s >= 16;
            bf16r* p1 = zr + base + axis * 32 + f;
            float x1 = __builtin_bit_cast(float, (unsigned)p1[0] << 16), x2 = __builtin_bit_cast(float, (unsigned)p1[16] << 16);
            float ss = x1 * x1 + x2 * x2;
#pragma unroll
            for (int o = 1; o < 32; o <<= 1) ss += __shfl_xor(ss, o);
            if (nrm) { const float* g = (s < 24) ? qng : kng; const float rr = 1.f / sqrtf(ss * (1.f / 64.f) + LN_EPS); x1 = x1 * rr * g[axis * 32 + f]; x2 = x2 * rr * g[axis * 32 + 16 + f]; }
            float o1 = x1 * cs - x2 * sn, o2 = x2 * cs + x1 * sn;
            if (isq) { o1 *= C2; o2 *= C2; }
            p1[0] = (bf16r)f2bf(o1); p1[16] = (bf16r)f2bf(o2);
        }
    }
}

__device__ __forceinline__ void combine_pass(int vcu, int G, const bf16r* DS, bf16r* O, const float* dlam, const float* subg, float lam_init, bool ctx_too) {
    PHASE_IDS();
    const float l1 = wave_sum(dlam[lane] * dlam[64 + lane]), l2 = wave_sum(dlam[128 + lane] * dlam[192 + lane]);
    const float lam = expf(l1) - expf(l2) + lam_init;
    const int head = lane >> 4, c = (lane & 15) * 8;
    float g[8];
#pragma unroll
    for (int i = 0; i < 8; ++i) g[i] = subg[c + i] * (1.0f - lam_init);
    for (int m = gw; m < MT; m += NGW) {
        const int b = m / TPB, r = m - b * TPB; if (!ctx_too && r < CTXL) continue;
        const v4u a = *(const v4u*)(DS + (size_t)m * DM + head * 256 + c), bq = *(const v4u*)(DS + (size_t)m * DM + head * 256 + 128 + c);
        float o[8];
        o[0] = bflo(a.x) - lam * bflo(bq.x); o[1] = bfhi(a.x) - lam * bfhi(bq.x); o[2] = bflo(a.y) - lam * bflo(bq.y); o[3] = bfhi(a.y) - lam * bfhi(bq.y);
        o[4] = bflo(a.z) - lam * bflo(bq.z); o[5] = bfhi(a.z) - lam * bfhi(bq.z); o[6] = bflo(a.w) - lam * bflo(bq.w); o[7] = bfhi(a.w) - lam * bfhi(bq.w);
        float ss = 0.f;
#pragma unroll
        for (int i = 0; i < 8; ++i) ss += o[i] * o[i];
#pragma unroll
        for (int x = 1; x < 16; x <<= 1) ss += __shfl_xor(ss, x);
        const float rr = 1.f / sqrtf(ss * (1.f / 128.f) + LN_EPS);
        v4u w; w.x = pk2(o[0] * rr * g[0], o[1] * rr * g[1]); w.y = pk2(o[2] * rr * g[2], o[3] * rr * g[3]); w.z = pk2(o[4] * rr * g[4], o[5] * rr * g[5]); w.w = pk2(o[6] * rr * g[6], o[7] * rr * g[7]);
        *(v4u*)(O + (size_t)m * DM + head * 128 + c) = w;
    }
}

__device__ __forceinline__ void conv_loadu(const bf16r* Z, int m, int lo, int hi, int c0, float (&u)[8]) {
    if (m < lo || m >= hi) {
#pragma unroll
        for (int i = 0; i < 8; ++i) u[i] = 0.f;
        return; }
    const v4u a = *(const v4u*)(Z + (size_t)m * ZC + 1024 + c0), x = *(const v4u*)(Z + (size_t)m * ZC + 2048 + c0);
    u[0] = bflo(a.x) * bflo(x.x); u[1] = bfhi(a.x) * bfhi(x.x); u[2] = bflo(a.y) * bflo(x.y); u[3] = bfhi(a.y) * bfhi(x.y);
    u[4] = bflo(a.z) * bflo(x.z); u[5] = bfhi(a.z) * bfhi(x.z); u[6] = bflo(a.w) * bflo(x.w); u[7] = bfhi(a.w) * bfhi(x.w);
}
__device__ __forceinline__ void conv_pass(int vcu, int G, const bf16r* Z, bf16r* O, const float* cw, const float* cb, bool lat_only) {
    PHASE_IDS();
    for (int it = gw; it < (MT / 16) * 2; it += NGW) {
        const int strip = it >> 1, hf = it & 1, m0 = strip * 16; const int b = m0 / TPB, r = m0 - b * TPB; const bool ctx = r < CTXL;
        if (lat_only && ctx) continue;
        const int lo = ctx ? b * TPB : b * TPB + CTXL, hi = ctx ? b * TPB + CTXL : (b + 1) * TPB;
        const int c0 = hf * 512 + lane * 8;
        float w0[8], w1[8], w2[8], bs[8];
#pragma unroll
        for (int i = 0; i < 8; ++i) { w0[i] = cw[c0 + i]; w1[i] = cw[DM + c0 + i]; w2[i] = cw[2 * DM + c0 + i]; bs[i] = cb[c0 + i]; }
        float up[8], uc[8], un[8];
        conv_loadu(Z, m0 - 1, lo, hi, c0, up); conv_loadu(Z, m0, lo, hi, c0, uc);
#pragma unroll 1
        for (int i = 0; i < 16; ++i) {
            const int m = m0 + i;
            conv_loadu(Z, m + 1, lo, hi, c0, un);
            const v4u gb = *(const v4u*)(Z + (size_t)m * ZC + c0);
            float y[8];
#pragma unroll
            for (int k = 0; k < 8; ++k) y[k] = up[k] * w0[k] + uc[k] * w1[k] + un[k] * w2[k] + bs[k];
            v4u w; w.x = pk2(bflo(gb.x) * y[0], bfhi(gb.x) * y[1]); w.y = pk2(bflo(gb.y) * y[2], bfhi(gb.y) * y[3]);
            w.z = pk2(bflo(gb.z) * y[4], bfhi(gb.z) * y[5]); w.w = pk2(bflo(gb.w) * y[6], bfhi(gb.w) * y[7]);
            *(v4u*)(O + (size_t)m * DM + c0) = w;
#pragma unroll
            for (int k = 0; k < 8; ++k) { up[k] = uc[k]; uc[k] = un[k]; }
        }
    }
}
#ifdef NO_GEMM
#define GEMMCALL1 if(0)
#define GEMMCALL2 if(0)
#define GEMMCALL3 if(0)
#define GEMMCALL4 if(0)
#endif
#ifndef GEMMCALL1
#define GEMMCALL1
#endif
#ifndef GEMMCALL2
#define GEMMCALL2
#endif
#ifndef GEMMCALL3
#define GEMMCALL3
#endif
#ifndef GEMMCALL4
#define GEMMCALL4
#endif
#define GSYNC() do { asm volatile("s_waitcnt vmcnt(0) lgkmcnt(0)" ::: "memory"); grid.sync(); } while (0)
__global__ void __launch_bounds__(NWAVES * 64) fwd_kernel(Args args) {
    extern __shared__ __attribute__((aligned(16))) unsigned char lds[];
    cg::grid_group grid = cg::this_grid();
    LAS unsigned char* ldsl = (LAS unsigned char*)lds;
    const int G = gridDim.x, bx = blockIdx.x;
    const int vcu = (G % 8 == 0) ? (bx % 8) * (G / 8) + bx / 8 : bx;
    unsigned char* ws = args.ws;
    float* mod = (float*)(ws + WS_MOD); float* xctx = (float*)(ws + WS_XCTX); float* xlat = args.out;
    bf16r* WinA = (bf16r*)(ws + WS_WINA); bf16r* WoutA = (bf16r*)(ws + WS_WOUTA); bf16r* WinC = (bf16r*)(ws + WS_WINC); bf16r* WoutC = (bf16r*)(ws + WS_WOUTC);
    bf16r* W1t = (bf16r*)(ws + WS_W1); bf16r* W2t = (bf16r*)(ws + WS_W2);
    bf16r* H = (bf16r*)(ws + WS_H); bf16r* O = (bf16r*)(ws + WS_O); bf16r* Z = (bf16r*)(ws + WS_Z); bf16r* DS = (bf16r*)(ws + WS_DS); bf16r* HID = (bf16r*)(ws + WS_HID);

    {
    PHASE_IDS(); const int tid = tid_l;
    if (bx < 192) {
        LAS float* cact = (LAS float*)ldsl;
        LAS float* red = (LAS float*)(ldsl + 36864);
        const float* cin = args.in[I_C]; const float* ccin = args.in[I_CCTX];
        for (int i = tid; i < 9 * 1024; i += NWAVES * 64) { const int s = i >> 10, k = i & 1023; const float v = s < 8 ? cin[s * 1024 + k] : ccin[k]; cact[i] = v / (1.0f + expf(-v)); }
        __syncthreads();
        const int l = bx / 48, cgp = bx % 48, n0 = cgp * 128 + lane * 2;
        const float* W = args.in[I_ADAW] + (size_t)l * 1024 * NMOD;
        float acc[9][2];
#pragma unroll
        for (int s = 0; s < 9; ++s) { acc[s][0] = 0.f; acc[s][1] = 0.f; }
#pragma unroll 8
        for (int kk = 0; kk < 128; ++kk) { const int k = wave * 128 + kk; const float2 w = *(const float2*)(W + (size_t)k * NMOD + n0);
#pragma unroll
            for (int s = 0; s < 9; ++s) { const float a = cact[s * 1024 + k]; acc[s][0] += a * w.x; acc[s][1] += a * w.y; } }
#pragma unroll
        for (int s = 0; s < 9; ++s) { red[(wave * 18 + s * 2) * 64 + lane] = acc[s][0]; red[(wave * 18 + s * 2 + 1) * 64 + lane] = acc[s][1]; }
        __syncthreads();
        for (int o = tid; o < 9 * 128; o += NWAVES * 64) { const int s = o >> 7, n = o & 127, ln = n >> 1, j = n & 1; float sum = 0.f;
#pragma unroll
            for (int w = 0; w < 8; ++w) sum += red[(w * 18 + s * 2 + j) * 64 + ln];
            mod[(size_t)(l * 9 + s) * NMOD + cgp * 128 + n] = sum + args.in[I_ADAB][l * NMOD + cgp * 128 + n]; }
        __syncthreads();
    }
    {
        LAS float* scr = (LAS float*)(ldsl + wave * 16384);
        constexpr int I_A = 16 * 72, I_S = 16 * 32, I_C3 = 16 * 96, I_M = 16 * 128;
        constexpr int NITEMS = 2 * I_A + 2 * I_S + 2 * I_C3 + 2 * I_S + 4 * I_M + 4 * I_M;
        for (int it = gw; it < NITEMS; it += NGW) {
            int r = it;
            if (r < 2 * I_A) { const int e = r / I_A; p0_transpose_item(args.in[I_AWIN] + (size_t)e * 1024 * ZA, 1024, ZA, WinA + (size_t)e * ZA * 1024, scr, r % I_A, lane); continue; } r -= 2 * I_A;
            if (r < 2 * I_S) { const int e = r / I_S; p0_transpose_item(args.in[I_AWOUT] + (size_t)e * 1024 * 1024, 1024, 1024, WoutA + (size_t)e * 1024 * 1024, scr, r % I_S, lane); continue; } r -= 2 * I_S;
            if (r < 2 * I_C3) { const int e = r / I_C3; p0_transpose_item(args.in[I_CWIN] + (size_t)e * 1024 * ZC, 1024, ZC, WinC + (size_t)e * ZC * 1024, scr, r % I_C3, lane); continue; } r -= 2 * I_C3;
            if (r < 2 * I_S) { const int e = r / I_S; p0_transpose_item(args.in[I_CWOUT] + (size_t)e * 1024 * 1024, 1024, 1024, WoutC + (size_t)e * 1024 * 1024, scr, r % I_S, lane); continue; } r -= 2 * I_S;
            if (r < 4 * I_M) { const int e = r / I_M; p0_transpose_item(args.in[I_W1] + (size_t)e * 1024 * FF, 1024, FF, W1t + (size_t)e * FF * 1024, scr, r % I_M, lane); continue; } r -= 4 * I_M;
            { const int e = r / I_M; p0_transpose_item(args.in[I_W2] + (size_t)e * FF * 1024, FF, 1024, W2t + (size_t)e * 1024 * FF, scr, r % I_M, lane); }
        }
    }
    }
    GSYNC();
    row_pass<true>(vcu, G, args.in[I_X], args.in[I_CTX], xlat, xctx, H, nullptr, nullptr, mod, 0, false);
    GSYNC();
#ifndef SKEL_ONLY
#pragma unroll 1
    for (int l = 0; l < 4; ++l) {
        const bool even = (l & 1) == 0; const int e = l >> 1;
        const float* mod_l = mod + (size_t)l * 9 * NMOD;
        const int latA = (l == 3) ? 1 : 0;
        const int latB = (l >= 2) ? 1 : 0;
        {
            pg8::Gemm g{H, even ? WinA + (size_t)e * ZA * 1024 : WinC + (size_t)e * ZC * 1024, MT, even ? ZA : ZC, DM};
            pg8::StaticOrder S; S.init(latA ? 128 : 136, (even ? ZA : ZC) / 256, G, bx, latA);
            pg8::EpiBf16<0> E{Z, even ? ZA : ZC};
            GEMMCALL1 pg8::gemm_phase<pg8::EpiBf16<0>, pg8::StaticOrder, true, true>(ldsl, g, S, E);
        }
        GSYNC();
        if (even) {
            postproj_pass(vcu, G, Z, args.in[I_QNG] + e * 64, args.in[I_KNG] + e * 64);
            GSYNC();
            {
                const int nmain = 3072, ntot = nmain + (l == 0 ? 192 : 0);
                for (int idx = vcu; idx < ntot; idx += G) {
                    int b, hitem, qrow0, NT;
                    if (idx < nmain) { int j; if (G == 256) { const int i = idx >> 8, vc = idx & 255; b = vc >> 5; j = i * 32 + (vc & 31); } else { b = idx / 384; j = idx % 384; }
                        hitem = j >> 4; qrow0 = b * TPB + CTXL + (j & 15) * 256; NT = TPB / 64; }
                    else { const int c = idx - nmain; b = c / 24; hitem = c % 24; qrow0 = b * TPB; NT = CTXL / 64; }
                    int qcol, kcol, vcol, ocol; bf16r* Ob;
                    if (hitem < 8) { qcol = 1536 + hitem * 64; kcol = 2048 + (hitem >> 2) * 64; vcol = 2176 + (hitem >> 2) * 64; ocol = 512 + hitem * 64; Ob = O; }
                    else { const int d = hitem - 8, hd = d >> 2, mp = (d >> 1) & 1, vh = d & 1; qcol = hd * 128 + mp * 64; kcol = 512 + hd * 128 + mp * 64; vcol = 1024 + hd * 128 + vh * 64; ocol = (hd * 2 + mp) * 128 + vh * 64; Ob = DS; }
                    const size_t krow0 = (size_t)b * TPB;
#ifndef NO_ATTN
                    attn_body::attn_unit<8>((const attn_body::bf16*)(Z + (size_t)qrow0 * ZA + qcol), (const attn_body::bf16*)(Z + krow0 * ZA + kcol), (const attn_body::bf16*)(Z + krow0 * ZA + vcol),
                                            (attn_body::bf16*)(Ob + (size_t)qrow0 * DM + ocol), NT, (char*)lds);
#endif
                }
            }
            GSYNC();
            combine_pass(vcu, G, DS, O, args.in[I_DLAM] + e * 256, args.in[I_DSUBG] + e * 128, l == 0 ? 0.2f : 0.4707130183435842f, l == 0);
            GSYNC();
        } else {
            conv_pass(vcu, G, Z, O, args.in[I_CW] + e * 3 * DM, args.in[I_CB] + e * DM, latA != 0);
            GSYNC();
        }
        {
            pg8::Gemm g{O, even ? WoutA + (size_t)e * 1024 * 1024 : WoutC + (size_t)e * 1024 * 1024, MT, DM, DM};
            pg8::StaticOrder S; S.init(latB ? 128 : 136, DM / 256, G, bx, latB);
            pg8::EpiResid E{xlat, xctx, mod_l, 2, DN_ALPHA};
            GEMMCALL2 pg8::gemm_phase<pg8::EpiResid, pg8::StaticOrder, true, true>(ldsl, g, S, E);
        }
        GSYNC();
        row_pass<false>(vcu, G, nullptr, nullptr, xlat, xctx, H, args.in[I_LNG] + (l * 2) * DM, args.in[I_LNB] + (l * 2) * DM, mod_l, 3, latB != 0);
        GSYNC();
        {
            pg8::Gemm g{H, W1t + (size_t)l * FF * 1024, MT, FF, DM};
            pg8::StaticOrder S; S.init(latB ? 128 : 136, FF / 256, G, bx, latB);
            pg8::EpiBf16<2> E{HID, FF};
            GEMMCALL3 pg8::gemm_phase<pg8::EpiBf16<2>, pg8::StaticOrder, true, true>(ldsl, g, S, E);
        }
        GSYNC();
        {
            pg8::Gemm g{HID, W2t + (size_t)l * 1024 * FF, MT, DM, FF};
            pg8::StaticOrder S; S.init(latB ? 128 : 136, DM / 256, G, bx, latB);
            pg8::EpiResid E{xlat, xctx, mod_l, 5, DN_ALPHA};
            GEMMCALL4 pg8::gemm_phase<pg8::EpiResid, pg8::StaticOrder, true, true>(ldsl, g, S, E);
        }
        GSYNC();
        {
            const int latN = (l >= 2) ? 1 : 0;
            row_pass<false>(vcu, G, nullptr, nullptr, xlat, xctx, H, args.in[I_LNG] + (l * 2 + 1) * DM, args.in[I_LNB] + (l * 2 + 1) * DM, l < 3 ? mod + (size_t)(l + 1) * 9 * NMOD : nullptr, 0, latN != 0);
        }
        if (l < 3) GSYNC();
    }
#endif
}

extern "C" void kernel_launch(void* const* d_in, const int* in_sizes, int n_in, void* d_out, int out_size, void* d_ws, size_t ws_size, hipStream_t stream) {
    static int grid = 0;
    if (grid == 0) {
        if (n_in != 20 || ws_size < WS_END) { fprintf(stderr, "kernel_launch: need 20 inputs and >= %zu bytes of workspace; got n_in %d, ws %zu\n", (size_t)WS_END, n_in, ws_size); grid = -1; return; }
        int dev = 0, cus = 0, per_cu = 0;
        if (hipGetDevice(&dev) != hipSuccess || hipDeviceGetAttribute(&cus, hipDeviceAttributeMultiprocessorCount, dev) != hipSuccess) { grid = -1; return; }
        if (hipFuncSetAttribute((const void*)fwd_kernel, hipFuncAttributeMaxDynamicSharedMemorySize, LDS_BYTES) != hipSuccess) { fprintf(stderr, "kernel_launch: hipFuncSetAttribute failed\n"); grid = -1; return; }
        if (hipOccupancyMaxActiveBlocksPerMultiprocessor(&per_cu, (const void*)fwd_kernel, NWAVES * 64, LDS_BYTES) != hipSuccess || per_cu < 1) { fprintf(stderr, "kernel_launch: occupancy query says %d\n", per_cu); per_cu = 1; }
        (void)hipGetLastError();
        grid = cus * 1;
    }
    if (grid < 0) return;
    Args a{};
    for (int i = 0; i < 20; ++i) a.in[i] = (const float*)d_in[i];
    a.out = (float*)d_out; a.ws = (unsigned char*)d_ws;
    void* kargs[] = {&a};
    hipError_t e = hipLaunchCooperativeKernel((const void*)fwd_kernel, dim3(grid), dim3(NWAVES * 64), kargs, LDS_BYTES, stream);
    if (e != hipSuccess) fprintf(stderr, "kernel_launch: cooperative launch failed: %s (grid %d)\n", hipGetErrorString(e), grid);
}
```
